# Optimizing an MI355X kernel written in HIP

```python
import functools
import jax, jax.numpy as jnp
from jax import lax
import numpy as np

D_MODEL = 1024
BATCH = 4
SEQ = 4096
DEPTH = 1
DEC_BATCH = 128
DEC_SEQ = 8
PAST_LEN = 8192
PAGE_SIZE = 128

N_HEADS = 8
QK_NOPE_DIM = 128
QK_ROPE_DIM = 64
QK_HEAD_DIM = QK_NOPE_DIM + QK_ROPE_DIM
V_HEAD_DIM = 128
Q_LORA_RANK = 256
KV_LORA_RANK = 256
ROPE_BASE = 10000.0
ATTN_WIDTH = N_HEADS * V_HEAD_DIM
ATTN_SCALE = QK_HEAD_DIM ** -0.5
Q_BLOCK = 128
GMLP_GROUPS = 4
GMLP_WIDTH = 1024
GMLP_GROUP_DIM = GMLP_WIDTH // GMLP_GROUPS
CHUNK = 128
D_FF = 2816
EPS = 1e-6
NEG_INF = -1e30
IN_SIZES = (Q_LORA_RANK, KV_LORA_RANK, QK_ROPE_DIM, GMLP_WIDTH, GMLP_WIDTH, D_MODEL, D_MODEL)
IN_SPLIT_POINTS = tuple(int(s) for s in np.cumsum(IN_SIZES)[:-1])
D_IN = sum(IN_SIZES)

kernel_name = "mla_gmlp_macaron_hybrid_step"


def _rmsnorm(x, g):
    x32 = x.astype(jnp.float32)
    y = x32 * lax.rsqrt(jnp.mean(x32 * x32, axis=-1, keepdims=True) + EPS)
    return (y * g.astype(jnp.float32)).astype(x.dtype)


def _rope(x, pos):
    half = QK_ROPE_DIM // 2
    inv = ROPE_BASE ** (-jnp.arange(half, dtype=jnp.float32) / half)
    ang = pos.astype(jnp.float32)[:, None] * inv[None, :]
    ang = ang.reshape(ang.shape[0], *([1] * (x.ndim - 3)), half)
    cos, sin = jnp.cos(ang), jnp.sin(ang)
    x32 = x.astype(jnp.float32)
    x1, x2 = x32[..., :half], x32[..., half:]
    return jnp.concatenate([x1 * cos - x2 * sin, x1 * sin + x2 * cos], axis=-1).astype(x.dtype)


def _swiglu(x, w_gate, w_up, w_down):
    return (jax.nn.silu(x @ w_gate) * (x @ w_up)) @ w_down


def _expand_latent(c_kv, p):
    lead = c_kv.shape[:-1]
    k_nope = _rmsnorm((c_kv @ p["w_uk"]).reshape(*lead, N_HEADS, QK_NOPE_DIM), p["k_nope_norm"])
    vals = (c_kv @ p["w_uv"]).reshape(*lead, N_HEADS, V_HEAD_DIM)
    return k_nope, vals


def _attend(q_nope, q_rope, k_nope, k_rope, vals, q_pos, k_pos):
    s = jnp.einsum('nqhd,nkhd->nhqk', q_nope, k_nope) + jnp.einsum('nqhd,nkd->nhqk', q_rope, k_rope)
    s = s.astype(jnp.float32) * ATTN_SCALE
    s = jnp.where(k_pos[None, :] <= q_pos[:, None], s, NEG_INF)
    prob = jax.nn.softmax(s, axis=-1).astype(vals.dtype)
    return jnp.einsum('nhqk,nkhd->nqhd', prob, vals)


def _prompt_attend(q_nope, q_rope, c_kv, k_rope, p):
    n, t = q_nope.shape[:2]
    k_nope, vals = _expand_latent(c_kv, p)
    k_pos = jnp.arange(t)

    def block(i):
        start = i * Q_BLOCK
        qn = lax.dynamic_slice_in_dim(q_nope, start, Q_BLOCK, axis=1)
        qr = lax.dynamic_slice_in_dim(q_rope, start, Q_BLOCK, axis=1)
        return _attend(qn, qr, k_nope, k_rope, vals, start + jnp.arange(Q_BLOCK), k_pos)

    out = lax.map(block, jnp.arange(t // Q_BLOCK))
    return jnp.moveaxis(out, 0, 1).reshape(n, t, N_HEADS, V_HEAD_DIM)


def _sample_attend(q_nope, q_rope, c_kv, k_rope, p, cache_lat, cache_rope, page_table):
    n_new = q_nope.shape[1]
    past = page_table.shape[1] * PAGE_SIZE
    q_pos = past + jnp.arange(n_new)
    k_pos = jnp.arange(past + n_new)

    def per_seq(args):
        qn, qr, lat_new, kr_new, pt = args
        lat = jnp.concatenate([cache_lat[pt].reshape(past, KV_LORA_RANK), lat_new], axis=0)
        kr = jnp.concatenate([cache_rope[pt].reshape(past, QK_ROPE_DIM), kr_new], axis=0)
        k_nope, vals = _expand_latent(lat[None], p)
        return _attend(qn[None], qr[None], k_nope, kr[None], vals, q_pos, k_pos)[0]

    return lax.map(per_seq, (q_nope, q_rope, c_kv, k_rope, page_table))


def _spatial_gate(u, v, w_s, b_s, chunk_len):
    n, t, _ = v.shape
    vc = v.reshape(n, t // chunk_len, chunk_len, GMLP_GROUPS, GMLP_GROUP_DIM)
    causal = jnp.tril(jnp.ones((chunk_len, chunk_len), dtype=bool))
    w = jnp.where(causal[None], w_s[:, :chunk_len, :chunk_len], 0.0).astype(v.dtype)
    mix = jnp.einsum('gts,ncsgd->nctgd', w, vc) + jnp.transpose(b_s[:, :chunk_len])[None, None, :, :, None]
    return u * mix.reshape(n, t, GMLP_WIDTH)


def _layer(x, pos, attend_fn, chunk_len, p):
    n, t, _ = x.shape
    x = x + 0.5 * _swiglu(_rmsnorm(x, p["ffn1_norm"]), p["ffn1_w_gate"], p["ffn1_w_up"], p["ffn1_w_down"])
    h = _rmsnorm(x, p["mix_norm"])
    c_q, c_kv, k_rope, u, v, g_attn, g_gmlp = jnp.split(h @ p["w_in"], IN_SPLIT_POINTS, axis=-1)
    q = (_rmsnorm(c_q, p["q_lora_norm"]) @ p["w_uq"]).reshape(n, t, N_HEADS, QK_HEAD_DIM)
    q_nope = _rmsnorm(q[..., :QK_NOPE_DIM], p["q_nope_norm"])
    q_rope = _rope(_rmsnorm(q[..., QK_NOPE_DIM:], p["q_rope_norm"]), pos)
    c_kv = _rmsnorm(c_kv, p["kv_lora_norm"])
    k_rope = _rope(_rmsnorm(k_rope, p["k_rope_norm"]), pos)
    attn = attend_fn(q_nope, q_rope, c_kv, k_rope, p).reshape(n, t, ATTN_WIDTH)
    u = jax.nn.gelu(u, approximate=False)
    v = _rmsnorm(jax.nn.gelu(v, approximate=False).reshape(n, t, GMLP_GROUPS, GMLP_GROUP_DIM),
                 p["gmlp_v_norm"]).reshape(n, t, GMLP_WIDTH)
    gm = _spatial_gate(u, v, p["gmlp_w_s"], p["gmlp_b_s"], chunk_len)
    merged = jax.nn.sigmoid(g_attn) * (attn @ p["w_o_attn"]) + jax.nn.sigmoid(g_gmlp) * (gm @ p["w_o_gmlp"])
    x = x + merged @ p["w_out"]
    x = x + 0.5 * _swiglu(_rmsnorm(x, p["ffn2_norm"]), p["ffn2_w_gate"], p["ffn2_w_up"], p["ffn2_w_down"])
    return x, c_kv, k_rope, v


def setup_inputs(seed: int = 0) -> dict:
    key = jax.random.key(seed)
    ks = list(jax.random.split(key, 40))

    def nrm(shape, scale=1.0):
        return scale * jax.random.normal(ks.pop(), shape, jnp.float32)

    def gain(shape):
        return 1.0 + 0.01 * nrm(shape)

    n_pages = PAST_LEN // PAGE_SIZE
    n_used = DEC_BATCH * n_pages
    n_pool = (n_used * 5) // 4
    L = DEPTH
    x_prompt = nrm((BATCH, SEQ, D_MODEL))
    x_sample = nrm((DEC_BATCH, DEC_SEQ, D_MODEL))
    cache_kv_latent = nrm((L, n_pool, PAGE_SIZE, KV_LORA_RANK))
    cache_k_rope = nrm((L, n_pool, PAGE_SIZE, QK_ROPE_DIM))
    page_table = jax.random.permutation(ks.pop(), n_pool)[:n_used].reshape(DEC_BATCH, n_pages).astype(jnp.int32)
    return {
        "x_prompt": x_prompt,
        "x_sample": x_sample,
        "cache_kv_latent": cache_kv_latent,
        "cache_k_rope": cache_k_rope,
        "page_table": page_table,
        "ffn1_norm": gain((L, D_MODEL)),
        "ffn1_w_gate": nrm((L, D_MODEL, D_FF), D_MODEL ** -0.5),
        "ffn1_w_up": nrm((L, D_MODEL, D_FF), D_MODEL ** -0.5),
        "ffn1_w_down": nrm((L, D_FF, D_MODEL), D_FF ** -0.5),
        "mix_norm": gain((L, D_MODEL)),
        "w_in": nrm((L, D_MODEL, D_IN), D_MODEL ** -0.5),
        "q_lora_norm": gain((L, Q_LORA_RANK)),
        "w_uq": nrm((L, Q_LORA_RANK, N_HEADS * QK_HEAD_DIM), Q_LORA_RANK ** -0.5),
        "kv_lora_norm": gain((L, KV_LORA_RANK)),
        "w_uk": nrm((L, KV_LORA_RANK, N_HEADS * QK_NOPE_DIM), KV_LORA_RANK ** -0.5),
        "w_uv": nrm((L, KV_LORA_RANK, N_HEADS * V_HEAD_DIM), KV_LORA_RANK ** -0.5),
        "q_nope_norm": gain((L, QK_NOPE_DIM)),
        "q_rope_norm": gain((L, QK_ROPE_DIM)),
        "k_nope_norm": gain((L, QK_NOPE_DIM)),
        "k_rope_norm": gain((L, QK_ROPE_DIM)),
        "gmlp_v_norm": gain((L, GMLP_GROUPS, GMLP_GROUP_DIM)),
        "gmlp_w_s": nrm((L, GMLP_GROUPS, CHUNK, CHUNK), CHUNK ** -0.5),
        "gmlp_b_s": gain((L, GMLP_GROUPS, CHUNK)),
        "w_o_attn": nrm((L, ATTN_WIDTH, D_MODEL), ATTN_WIDTH ** -0.5),
        "w_o_gmlp": nrm((L, GMLP_WIDTH, D_MODEL), GMLP_WIDTH ** -0.5),
        "w_out": nrm((L, D_MODEL, D_MODEL), D_MODEL ** -0.5),
        "ffn2_norm": gain((L, D_MODEL)),
        "ffn2_w_gate": nrm((L, D_MODEL, D_FF), D_MODEL ** -0.5),
        "ffn2_w_up": nrm((L, D_MODEL, D_FF), D_MODEL ** -0.5),
        "ffn2_w_down": nrm((L, D_FF, D_MODEL), D_FF ** -0.5),
    }


def reference(x_prompt, x_sample, cache_kv_latent, cache_k_rope, page_table,
              ffn1_norm, ffn1_w_gate, ffn1_w_up, ffn1_w_down, mix_norm, w_in,
              q_lora_norm, w_uq, kv_lora_norm, w_uk, w_uv, q_nope_norm, q_rope_norm,
              k_nope_norm, k_rope_norm, gmlp_v_norm, gmlp_w_s, gmlp_b_s,
              w_o_attn, w_o_gmlp, w_out, ffn2_norm, ffn2_w_gate, ffn2_w_up, ffn2_w_down):
    t_prompt = x_prompt.shape[1]
    t_new = x_sample.shape[1]
    past = page_table.shape[1] * PAGE_SIZE
    pos_prompt = jnp.arange(t_prompt)
    pos_sample = past + jnp.arange(t_new)
    xp, xs = x_prompt, x_sample
    lat_p, rope_p, lat_s, rope_s, v_s = [], [], [], [], []
    for l in range(DEPTH):
        p = dict(
            ffn1_norm=ffn1_norm[l], ffn1_w_gate=ffn1_w_gate[l], ffn1_w_up=ffn1_w_up[l], ffn1_w_down=ffn1_w_down[l],
            mix_norm=mix_norm[l], w_in=w_in[l], q_lora_norm=q_lora_norm[l], w_uq=w_uq[l],
            kv_lora_norm=kv_lora_norm[l], w_uk=w_uk[l], w_uv=w_uv[l], q_nope_norm=q_nope_norm[l],
            q_rope_norm=q_rope_norm[l], k_nope_norm=k_nope_norm[l], k_rope_norm=k_rope_norm[l],
            gmlp_v_norm=gmlp_v_norm[l], gmlp_w_s=gmlp_w_s[l], gmlp_b_s=gmlp_b_s[l],
            w_o_attn=w_o_attn[l], w_o_gmlp=w_o_gmlp[l], w_out=w_out[l], ffn2_norm=ffn2_norm[l],
            ffn2_w_gate=ffn2_w_gate[l], ffn2_w_up=ffn2_w_up[l], ffn2_w_down=ffn2_w_down[l])
        xp, c_kv_p, k_rope_p, _ = _layer(xp, pos_prompt, _prompt_attend, CHUNK, p)
        attend_s = functools.partial(_sample_attend, cache_lat=cache_kv_latent[l],
                                     cache_rope=cache_k_rope[l], page_table=page_table)
        xs, c_kv_s, k_rope_s, v_rows_s = _layer(xs, pos_sample, attend_s, t_new, p)
        lat_p.append(c_kv_p)
        rope_p.append(k_rope_p)
        lat_s.append(c_kv_s)
        rope_s.append(k_rope_s)
        v_s.append(v_rows_s)
    new_kv_latent_prompt = jnp.stack(lat_p)
    new_k_rope_prompt = jnp.stack(rope_p)
    new_kv_latent_sample = jnp.stack(lat_s)
    new_k_rope_sample = jnp.stack(rope_s)
    new_gmlp_v_sample = jnp.stack(v_s)
    return (xp, xs, new_kv_latent_prompt, new_k_rope_prompt, new_kv_latent_sample, new_k_rope_sample, new_gmlp_v_sample)
```

```cpp
#include <hip/hip_runtime.h>
#include <cstdio>
#include <cstdint>
namespace pg8 {
#define PG8_LAS __attribute__((address_space(3)))
typedef unsigned short bf16_t;
typedef short bf16x8 __attribute__((ext_vector_type(8)));
typedef float f32x4 __attribute__((ext_vector_type(4)));
typedef unsigned u32x4 __attribute__((ext_vector_type(4)));
constexpr int BM = 256, BK = 64, HALF = 128, HTB = HALF * BK * 2  , STAGE_BYTES = 8 * HTB, NXCD = 8, WGM = 8;

__host__ __device__ __forceinline__ int lds_byte(int r, int c) { const int st = (r >> 4) * 2 + (c >> 5), rr = r & 15, cc = c & 31, ob = rr * 64 + cc * 2; return st * 1024 + (ob ^ (((ob >> 9) & 1) << 5)); }
__host__ __device__ __forceinline__ void stage_rc(int b, int& R, int& C) { const int st = b / 1024, sb = b % 1024, swz = sb ^ (((sb >> 9) & 1) << 5); R = (st >> 1) * 16 + swz / 64; C = (st & 1) * 32 + (swz % 64) / 2; }
__host__ __device__ __forceinline__ int perm32(int rho) { const int n = rho >> 4, i = rho & 15; return 8 * (i >> 2) + 4 * n + (i & 3); }

struct Unit { int pm, pn; };
struct Gemm { const bf16_t* A; const bf16_t* Bt; int M, N, K; };

struct StaticOrder {
    int nM, nN, nwg, G, c;
    __host__ __device__ void init(int M, int N, int G_, int c_) { nM = M / BM; nN = N / BM; nwg = nM * nN; G = G_; c = c_; }
    __host__ __device__ __forceinline__ bool next(int i, Unit& u) const { return map((long)i * G + c, u); }
    __host__ __device__ __forceinline__ bool map(long L, Unit& u) const {
        if (L >= nwg) return false;
        int wgid = (int)L; { const int q = nwg / NXCD, r = nwg % NXCD, xcd = wgid % NXCD, off = wgid / NXCD; wgid = (xcd < r ? xcd * (q + 1) : r * (q + 1) + (xcd - r) * q) + off; }
        const int nig = WGM * nN, gid = wgid / nig, fm = gid * WGM, gsz = (nM - fm) < WGM ? (nM - fm) : WGM;
        u.pm = fm + ((wgid % nig) % gsz); u.pn = (wgid % nig) / gsz; return true;
    }
    __device__ __forceinline__ void a_ready(const Unit&) const {}
    __device__ __forceinline__ void done(const Unit&) const {}
};
struct CatOrder {
    StaticOrder S1, S2; int dpm, dpn;
    __device__ __forceinline__ bool next(int i, Unit& u) const {
        const long L = (long)i * S1.G + S1.c;
        if (L < S1.nwg) return S1.map(L, u);
        if (!S2.map(L - S1.nwg, u)) return false;
        u.pm += dpm; u.pn += dpn; return true; }
    __device__ __forceinline__ void a_ready(const Unit&) const {}
    __device__ __forceinline__ void done(const Unit&) const {}
};

__device__ __forceinline__ unsigned cvt_pk_bf16(float lo, float hi) { unsigned r; asm volatile("v_cvt_pk_bf16_f32 %0, %1, %2" : "=v"(r) : "v"(lo), "v"(hi)); return r; }
typedef float f32x2 __attribute__((ext_vector_type(2)));
__device__ __forceinline__ f32x2 gelu_pk(f32x2 v) {
    const f32x2 av = __builtin_elementwise_abs(v), d = av * 0.2316418882f + 1.0f;
    f32x2 t; t.x = __builtin_amdgcn_rcpf(d.x); t.y = __builtin_amdgcn_rcpf(d.y);
    f32x2 q = t * 0.5307027145f + (-0.7265760135f); q = q * t + 0.7107068705f; q = q * t + (-0.142248368f); q = q * t + 0.127414796f; q = q * t;
    const f32x2 s = (v * v) * (-0.72134752044f);
    f32x2 e; e.x = __builtin_amdgcn_exp2f(s.x); e.y = __builtin_amdgcn_exp2f(s.y);
    const f32x2 m = v * (q * e), r = v - m;
    f32x2 o; o.x = v.x < 0.f ? m.x : r.x; o.y = v.y < 0.f ? m.y : r.y; return o;
}

template <class Epi, class Sched, bool ALIGN_EPI = false, bool SP2 = false>
__device__ __forceinline__ void gemm_phase(PG8_LAS unsigned char* lds, const Gemm g, const Sched& S, const Epi& E) {
    int tid_ = threadIdx.x; asm volatile("" : "+v"(tid_));
    const int tid = tid_, wid = __builtin_amdgcn_readfirstlane(tid >> 6), lane = tid & 63, wr = wid >> 2, wc = wid & 3, fr = lane & 15, fq = lane >> 4;
    const int K = g.K, nt = K / BK;
    unsigned voffA[2], voffB[2];
#pragma unroll
    for (int i = 0; i < 2; ++i) { int R, C; stage_rc(tid * 16 + i * 8192, R, C); const int Rb = Epi::PERM ? ((R & ~31) + perm32(R & 31)) : R;
        voffA[i] = (unsigned)(R * K + C) * 2u; voffB[i] = (unsigned)(Rb * K + C) * 2u; }
    const size_t kstep = (size_t)(BK * 2);
    const size_t hstep = (size_t)HALF * K * 2;
    const size_t tstep = 2 * hstep;
    const unsigned ldsw = (unsigned)wid * 1024u;
    const int aoff = lds_byte(wr * 64 + fr, fq * 8), boff = lds_byte(wc * 32 + fr, fq * 8);
#define PG8_SA(b, h) (((b) * 2 + (h)) * HTB)
#define PG8_SB(b, h) ((4 + (b) * 2 + (h)) * HTB)
#define PG8_STAGE(bufoff, gbase, voff) do { _Pragma("unroll") for (int _i = 0; _i < 2; ++_i) \
        __builtin_amdgcn_global_load_lds((const unsigned*)((const char*)(gbase) + (voff)[_i]), (PG8_LAS unsigned*)(lds + (bufoff) + ldsw + _i * 8192), 16, 0, 0); } while (0)
#define PG8_LDA(dst, b, h) do { _Pragma("unroll") for (int m = 0; m < 4; ++m) _Pragma("unroll") for (int k = 0; k < 2; ++k) dst[m][k] = *(const PG8_LAS bf16x8*)(lds + PG8_SA(b, h) + aoff + m * 2048 + k * 1024); } while (0)
#define PG8_LDB(dst, b, h) do { _Pragma("unroll") for (int n = 0; n < 2; ++n) _Pragma("unroll") for (int k = 0; k < 2; ++k) dst[n][k] = *(const PG8_LAS bf16x8*)(lds + PG8_SB(b, h) + boff + n * 2048 + k * 1024); } while (0)
#define PG8_MMA(ai, bj, At, Bt) do { __builtin_amdgcn_s_setprio(1); _Pragma("unroll") for (int m = 0; m < 4; ++m) _Pragma("unroll") for (int n = 0; n < 2; ++n) _Pragma("unroll") for (int k = 0; k < 2; ++k) \
        acc[ai][bj][m][n] = __builtin_amdgcn_mfma_f32_16x16x32_bf16(Bt[n][k], At[m][k], acc[ai][bj][m][n], 0, 0, 0); __builtin_amdgcn_s_setprio(0); } while (0)
#define PG8_WAIT_V(n) asm volatile("s_waitcnt vmcnt(" #n ")" ::: "memory")
#define PG8_WAIT_L(n) asm volatile("s_waitcnt lgkmcnt(" #n ")" ::: "memory")
#define PG8_BAR __builtin_amdgcn_s_barrier()
#define PG8_SCHED __builtin_amdgcn_sched_barrier(0)
    Unit cur, nxt; int ui = 0;
    if (!S.next(0, cur)) return;
    f32x4 acc[2][2][4][2];
#pragma unroll
    for (int a = 0; a < 2; ++a)
#pragma unroll
        for (int b = 0; b < 2; ++b)
#pragma unroll
            for (int m = 0; m < 4; ++m)
#pragma unroll
                for (int n = 0; n < 2; ++n) acc[a][b][m][n] = (f32x4){0.f, 0.f, 0.f, 0.f};
    bf16x8 At[4][2], B0[2][2], B1[2][2];
    const char* cA = (const char*)g.A + (size_t)cur.pm * tstep; const char* cB = (const char*)g.Bt + (size_t)cur.pn * tstep;
    S.a_ready(cur);
    if constexpr (SP2) {
        PG8_STAGE(PG8_SB(0, 0), cB, voffB); PG8_STAGE(PG8_SB(0, 1), cB + hstep, voffB); PG8_STAGE(PG8_SA(0, 0), cA, voffA); PG8_STAGE(PG8_SA(0, 1), cA + hstep, voffA);
        if (wr == 1) PG8_BAR;
        PG8_WAIT_V(2); PG8_BAR;
        PG8_STAGE(PG8_SB(1, 0), cB + kstep, voffB); PG8_STAGE(PG8_SA(1, 0), cA + kstep, voffA); PG8_STAGE(PG8_SB(1, 1), cB + hstep + kstep, voffB);
        PG8_WAIT_V(6); PG8_BAR;
    } else {
        PG8_STAGE(PG8_SB(0, 0), cB, voffB); PG8_STAGE(PG8_SA(0, 0), cA, voffA); PG8_STAGE(PG8_SB(0, 1), cB + hstep, voffB); PG8_STAGE(PG8_SA(0, 1), cA + hstep, voffA);
        if (wr == 1) PG8_BAR;
        PG8_WAIT_V(4); PG8_BAR;
        PG8_STAGE(PG8_SB(1, 0), cB + kstep, voffB); PG8_STAGE(PG8_SA(1, 0), cA + kstep, voffA); PG8_STAGE(PG8_SB(1, 1), cB + hstep + kstep, voffB);
        PG8_WAIT_V(6); PG8_BAR;
    }
    for (;;) {
        const bool has_next = S.next(ui + 1, nxt);
        const char* nA = has_next ? (const char*)g.A + (size_t)nxt.pm * tstep : cA; const char* nB = has_next ? (const char*)g.Bt + (size_t)nxt.pn * tstep : cB;
        for (int t = 0; t < nt; t += 2) {
            const bool last = (t == nt - 2);
            const char* a1 = cA + (size_t)(t + 1) * kstep;
            const char* a2 = last ? nA : cA + (size_t)(t + 2) * kstep; const char* b2 = last ? nB : cB + (size_t)(t + 2) * kstep;
            const char* a3 = a2 + kstep; const char* b3 = b2 + kstep;
            if (last && has_next) S.a_ready(nxt);
            if constexpr (SP2) {
            PG8_LDB(B0, 0, 0); PG8_LDB(B1, 0, 1); PG8_SCHED; PG8_LDA(At, 0, 0); PG8_STAGE(PG8_SA(1, 1), a1 + hstep, voffA);
            PG8_WAIT_V(8); PG8_WAIT_L(0); PG8_BAR; PG8_MMA(0, 0, At, B0); PG8_MMA(0, 1, At, B1); PG8_BAR; PG8_SCHED;
            PG8_LDA(At, 0, 1); PG8_STAGE(PG8_SB(0, 0), b2, voffB); PG8_STAGE(PG8_SB(0, 1), b2 + hstep, voffB); PG8_STAGE(PG8_SA(0, 0), a2, voffA);
            PG8_WAIT_V(8); PG8_WAIT_L(0); PG8_BAR; PG8_MMA(1, 0, At, B0); PG8_MMA(1, 1, At, B1); PG8_BAR; PG8_SCHED;
            PG8_LDB(B0, 1, 0); PG8_LDB(B1, 1, 1); PG8_SCHED; PG8_LDA(At, 1, 0); PG8_STAGE(PG8_SA(0, 1), a2 + hstep, voffA);
            PG8_WAIT_V(8); PG8_WAIT_L(0); PG8_BAR; PG8_MMA(0, 0, At, B0); PG8_MMA(0, 1, At, B1); PG8_BAR; PG8_SCHED;
            PG8_LDA(At, 1, 1); PG8_STAGE(PG8_SB(1, 0), b3, voffB); PG8_STAGE(PG8_SB(1, 1), b3 + hstep, voffB); PG8_STAGE(PG8_SA(1, 0), a3, voffA);
            PG8_WAIT_V(8); PG8_WAIT_L(0); PG8_BAR; PG8_MMA(1, 0, At, B0); PG8_MMA(1, 1, At, B1); PG8_BAR; PG8_SCHED;
            } else {
            PG8_LDB(B0, 0, 0); PG8_SCHED; PG8_LDA(At, 0, 0); PG8_STAGE(PG8_SA(1, 1), a1 + hstep, voffA);
            PG8_WAIT_L(8); PG8_BAR; PG8_WAIT_L(0); PG8_MMA(0, 0, At, B0); PG8_BAR; PG8_SCHED;
            PG8_LDB(B1, 0, 1); PG8_STAGE(PG8_SB(0, 0), b2, voffB);
            PG8_BAR; PG8_WAIT_L(0); PG8_MMA(0, 1, At, B1); PG8_BAR;
            PG8_LDA(At, 0, 1); PG8_STAGE(PG8_SA(0, 0), a2, voffA);
            PG8_BAR; PG8_WAIT_L(0); PG8_MMA(1, 0, At, B0); PG8_BAR; PG8_SCHED;
            PG8_STAGE(PG8_SB(0, 1), b2 + hstep, voffB);
            PG8_WAIT_V(6); PG8_BAR; PG8_MMA(1, 1, At, B1); PG8_BAR;
            PG8_LDB(B0, 1, 0); PG8_SCHED; PG8_LDA(At, 1, 0); PG8_STAGE(PG8_SA(0, 1), a2 + hstep, voffA);
            PG8_WAIT_L(8); PG8_BAR; PG8_WAIT_L(0); PG8_MMA(0, 0, At, B0); PG8_BAR; PG8_SCHED;
            PG8_LDB(B1, 1, 1); PG8_STAGE(PG8_SB(1, 0), b3, voffB);
            PG8_BAR; PG8_WAIT_L(0); PG8_MMA(0, 1, At, B1); PG8_BAR;
            PG8_LDA(At, 1, 1); PG8_STAGE(PG8_SA(1, 0), a3, voffA);
            PG8_BAR; PG8_WAIT_L(0); PG8_MMA(1, 0, At, B0); PG8_BAR; PG8_SCHED;
            PG8_STAGE(PG8_SB(1, 1), b3 + hstep, voffB);
            PG8_WAIT_V(6); PG8_BAR; PG8_MMA(1, 1, At, B1); PG8_BAR;
            }
        }
        if constexpr (ALIGN_EPI) { if (wr == 0) PG8_BAR; }
        if constexpr (!Epi::AFTER_DRAIN) { E(acc, cur, wr, wc, fr, fq); S.done(cur); }
        if (!has_next) break;
#pragma unroll
        for (int a = 0; a < 2; ++a)
#pragma unroll
            for (int b = 0; b < 2; ++b)
#pragma unroll
                for (int m = 0; m < 4; ++m)
#pragma unroll
                    for (int n = 0; n < 2; ++n) acc[a][b][m][n] = (f32x4){0.f, 0.f, 0.f, 0.f};
        cur = nxt; cA = nA; cB = nB; ++ui;
        if constexpr (ALIGN_EPI) { if (wr == 1) PG8_BAR; }
    }
    PG8_WAIT_V(0);
    if constexpr (!ALIGN_EPI) { if (wr == 0) PG8_BAR; }
    PG8_BAR;
    if constexpr (Epi::AFTER_DRAIN) { E.fused(acc, cur, wr, wc, fr, fq, lds, wid, lane); S.done(cur); }
#undef PG8_SA
#undef PG8_SB
#undef PG8_STAGE
#undef PG8_LDA
#undef PG8_LDB
#undef PG8_MMA
#undef PG8_WAIT_V
#undef PG8_WAIT_L
#undef PG8_BAR
#undef PG8_SCHED
}
}
#define LAS __attribute__((address_space(3)))
#define XB_TMO      128
#define XB_XCNT(j)  (256  + 64 * (j))
#define XB_XSUB(j)  (1280 + 64 * (j))
#define XB_XGEN(j)  (2304 + 64 * (j))
#define XB_TOP      3328
#define XB_TOPGEN   3392
#define XCD_BAR_WORDS 3456
#define XB_SPIN_CAP (1u << 18)

__device__ __forceinline__ unsigned xb_ld(unsigned* p)              { return __hip_atomic_load(p, __ATOMIC_RELAXED, __HIP_MEMORY_SCOPE_AGENT); }
__device__ __forceinline__ unsigned xb_add(unsigned* p, unsigned v) { return __hip_atomic_fetch_add(p, v, __ATOMIC_RELAXED, __HIP_MEMORY_SCOPE_AGENT); }
__device__ __forceinline__ unsigned xb_xcc_id() { return (unsigned)__builtin_amdgcn_s_getreg((3 << 11) | 20) & 0xFu; }
#define XB_SPIN(cond, bar) do { unsigned _sp = 0; while (cond) { __builtin_amdgcn_s_sleep(1); \
    if ((++_sp & 255u) == 0u) { if (xb_ld(&(bar)[XB_TMO])) break; if (_sp > XB_SPIN_CAP) { atomicAdd(&(bar)[XB_TMO], 1u); break; } } } } while (0)

struct XcdBarrier {
    unsigned* bar; unsigned x;
    volatile LAS unsigned* st;
};

__device__ __forceinline__ XcdBarrier xcd_barrier_post(unsigned* bar, volatile LAS unsigned* st) {
    XcdBarrier b; b.bar = bar; b.x = xb_xcc_id(); b.st = st;
    if (threadIdx.x == 0) (void)xb_add(&bar[XB_XCNT(b.x)], 1u);
    return b;
}
__device__ __forceinline__ void xcd_barrier_complete(unsigned* bar, unsigned x, unsigned& nloc, unsigned& nx) {
    const unsigned G = gridDim.x * gridDim.y * gridDim.z;
    unsigned sum, cnt, mine, sp = 0u;
    for (;;) {
        sum = 0u; cnt = 0u; mine = 0u;
#pragma unroll
        for (unsigned j = 0; j < 16; ++j) { const unsigned c = xb_ld(&bar[XB_XCNT(j)]); sum += c; cnt += (c > 0u) ? 1u : 0u; mine = (j == x) ? c : mine; }
        if (sum == G) break;
        __builtin_amdgcn_s_sleep(1);
        if ((++sp & 255u) == 0u) { if (xb_ld(&bar[XB_TMO])) break; if (sp > XB_SPIN_CAP) { atomicAdd(&bar[XB_TMO], 1u); break; } }
    }
    nloc = mine > 0u ? mine : 1u; nx = cnt > 0u ? cnt : 1u;
}

__device__ __forceinline__ void xcd_barrier(const XcdBarrier& b) {
    asm volatile("s_waitcnt vmcnt(0)" ::: "memory");
    __syncthreads();
    if (threadIdx.x == 0) {
        unsigned* bar = b.bar;
        __builtin_amdgcn_s_waitcnt(0);
        unsigned nloc = b.st[0], nx = b.st[1];
        if (nloc == 0u) { xcd_barrier_complete(bar, b.x, nloc, nx); b.st[0] = nloc; b.st[1] = nx; }
        const unsigned old = xb_add(&bar[XB_XSUB(b.x)], 1u);
        const unsigned gen = old / nloc;
        if (old + 1u == (gen + 1u) * nloc) {
            __builtin_amdgcn_fence(__ATOMIC_RELEASE, "agent");
            asm volatile("s_waitcnt vmcnt(0)" ::: "memory");
            const unsigned og = xb_add(&bar[XB_TOP], 1u);
            const unsigned tg = og / nx;
            if (og + 1u == (tg + 1u) * nx) xb_add(&bar[XB_TOPGEN], 1u);
            else XB_SPIN(xb_ld(&bar[XB_TOPGEN]) == tg, bar);
            __builtin_amdgcn_fence(__ATOMIC_ACQUIRE, "agent");
            xb_add(&bar[XB_XGEN(b.x)], 1u);
            asm volatile("s_waitcnt vmcnt(0)" ::: "memory");
        } else {
            XB_SPIN(xb_ld(&bar[XB_XGEN(b.x)]) == gen, bar);
            __builtin_amdgcn_fence(__ATOMIC_ACQUIRE, "agent");
            asm volatile("s_waitcnt vmcnt(0)" ::: "memory");
        }
    }
    __syncthreads();
}

#define DI __device__ __forceinline__
typedef float f32x16 __attribute__((ext_vector_type(16)));
typedef float f32x2 __attribute__((ext_vector_type(2)));
typedef unsigned u32x2 __attribute__((ext_vector_type(2)));
typedef short s16x4 __attribute__((ext_vector_type(4)));
typedef short v4i16_t __attribute__((ext_vector_type(4)));
typedef __bf16 bf16x2_t __attribute__((ext_vector_type(2)));

constexpr int DM = 1024, NP = 16384, NS = 1024, MT = NP + NS;
constexpr int DFF = 2816, NGU = 2 * DFF, NIN = 4864, NSM = 768;
constexpr int SEQ = 4096, DEC_B = 128, DEC_T = 8, PAST = 8192, PAGE = 128, NPAGES = 64;
constexpr int NH = 8, DN = 128, DR = 64, DQ = 192, DVH = 128, RL = 256, NQ = NH * DQ;
constexpr int SKEYS = 8448;
constexpr int MR = DEC_B * SKEYS;
constexpr float EPS = 1e-6f;
constexpr float QSCALE = 0.07216878364870322f * 1.4426950408889634f;
constexpr int NWAVES = 8;

constexpr size_t al256(size_t x) { return (x + 255) & ~(size_t)255; }
constexpr size_t WS_CTL = 0, CTL_ZERO_BYTES = 32768;
constexpr size_t WS_W1GU = 1u << 20;
constexpr size_t WS_W1D  = WS_W1GU + al256((size_t)NGU * DM * 2);
constexpr size_t WS_W2GU = WS_W1D + al256((size_t)DM * DFF * 2);
constexpr size_t WS_W2D  = WS_W2GU + al256((size_t)NGU * DM * 2);
constexpr size_t WS_WIN  = WS_W2D + al256((size_t)DM * DFF * 2);
constexpr size_t WS_WUQ  = WS_WIN + al256((size_t)NIN * DM * 2);
constexpr size_t WS_WUKV = WS_WUQ + al256((size_t)NQ * RL * 2);
constexpr size_t WS_WUKO = WS_WUKV + al256((size_t)2048 * RL * 2);
constexpr size_t WS_WOA  = WS_WUKO + al256((size_t)RL * 1024 * 2);
constexpr size_t WS_WOG  = WS_WOA + al256((size_t)DM * DM * 2);
constexpr size_t WS_WOUT = WS_WOG + al256((size_t)DM * DM * 2);
constexpr size_t WS_WST  = WS_WOUT + al256((size_t)DM * DM * 2);
constexpr size_t WS_WF   = WS_WST + al256((size_t)4 * 128 * 128 * 2);
constexpr size_t WS_A    = WS_WF + al256((size_t)RL * 1024 * 2);
constexpr size_t WS_H    = WS_A + al256((size_t)MT * DM * 2);
constexpr size_t WS_SM   = WS_H + al256((size_t)MT * DFF * 2);
constexpr size_t WS_U    = WS_SM + al256((size_t)MT * NSM * 4);
constexpr size_t WS_VG   = WS_U + al256((size_t)MT * DM * 2);
constexpr size_t WS_GA   = WS_VG + al256((size_t)MT * DM * 2);
constexpr size_t WS_GG   = WS_GA + al256((size_t)MT * DM * 2);
constexpr size_t WS_CQN  = WS_GG + al256((size_t)MT * DM * 2);
constexpr size_t WS_LATB = WS_CQN + al256((size_t)MT * RL * 2);
constexpr size_t WS_KRB  = WS_LATB + al256((size_t)MT * RL * 2);
constexpr size_t WS_QN   = WS_KRB + al256((size_t)MT * DR * 2);
constexpr size_t WS_KRAW = WS_QN + al256((size_t)MT * NQ * 2);
constexpr size_t WS_VB   = WS_KRAW + al256((size_t)MT * DM * 2);
constexpr size_t WS_K192 = WS_VB + al256((size_t)MT * DM * 2);
constexpr size_t WS_CB   = WS_K192 + al256((size_t)NP * NQ * 2);
constexpr size_t WS_KRC  = WS_CB + al256((size_t)MR * RL * 2);
constexpr size_t WS_RS   = WS_KRC + al256((size_t)MR * DR * 2);
constexpr size_t WS_PO   = WS_RS + al256((size_t)MR * NH * 4);
constexpr size_t WS_PML  = WS_PO + al256((size_t)256 * 8 * 256 * 32 * 4);
constexpr size_t WS_ATT  = WS_PML + al256((size_t)256 * 8 * 32 * 2 * 4);
constexpr size_t WS_GM   = WS_ATT + al256((size_t)MT * DM * 2);
constexpr size_t WS_M1   = WS_GM + al256((size_t)MT * DM * 2);
constexpr size_t WS_MRG  = WS_M1 + al256((size_t)MT * DM * 4);
constexpr size_t WS_RSP  = WS_MRG + al256((size_t)MT * DM * 2);
constexpr size_t RSP_TAB = ((size_t)NP * 16 + (size_t)NS * 128) * 4;
constexpr size_t WS_END  = WS_RSP + al256(2 * RSP_TAB);
constexpr size_t WS_Q8 = WS_KRAW, WS_K8 = WS_K192;
constexpr int CW_BAR = 4096;

constexpr size_t OUT_X = 0;
constexpr size_t OUT_LATP = (size_t)MT * DM, OUT_ROPEP = OUT_LATP + (size_t)NP * RL, OUT_LATS = OUT_ROPEP + (size_t)NP * DR;
constexpr size_t OUT_ROPES = OUT_LATS + (size_t)NS * RL, OUT_VS = OUT_ROPES + (size_t)NS * DR, OUT_END = OUT_VS + (size_t)NS * DM;

constexpr int RING_BYTES = 131072;
constexpr int XCH_OFF = RING_BYTES;
constexpr int RTAB_OFF = RING_BYTES + 8192;
constexpr int MISC_OFF = 155648;
constexpr int LDS_BYTES = MISC_OFF + 512;

typedef unsigned short bf16;
typedef unsigned v4u __attribute__((ext_vector_type(4)));
using pg8::f32x4; using pg8::bf16x8; using pg8::u32x4;
#define GASP __attribute__((address_space(1)))

DI unsigned f2bf(float f) { unsigned u = __builtin_bit_cast(unsigned, f); return (u + 0x7fffu + ((u >> 16) & 1u)) >> 16; }
DI unsigned pk2(float lo, float hi) { f32x2 v = {lo, hi}; bf16x2_t b = __builtin_convertvector(v, bf16x2_t); return __builtin_bit_cast(unsigned, b); }
DI float bflo(unsigned w) { return __uint_as_float(w << 16); }
DI float bfhi(unsigned w) { return __uint_as_float(w & 0xffff0000u); }
DI float bf2f(bf16 b) { return __uint_as_float((unsigned)b << 16); }
DI float wave_sum(float v) {
#pragma unroll
    for (int o = 1; o < 64; o <<= 1) v += __shfl_xor(v, o);
    return v;
}
DI int crow(int r, int hi) { return (r & 3) + 8 * (r >> 2) + 4 * hi; }
DI float fexp2(float x) { return __builtin_amdgcn_exp2f(x); }
DI float sigmoidf_(float x) { return __builtin_amdgcn_rcpf(1.0f + fexp2(-1.4426950408889634f * x)); }
#define MFMA32(a, b, c) __builtin_amdgcn_mfma_f32_32x32x16_bf16((a), (b), (c), 0, 0, 0)
typedef int v8i_t __attribute__((ext_vector_type(8))); typedef int v4i_t __attribute__((ext_vector_type(4)));
DI unsigned fp8x4(float a, float b, float c, float d) { return (unsigned)__builtin_amdgcn_cvt_pk_fp8_f32(c, d, __builtin_amdgcn_cvt_pk_fp8_f32(a, b, 0, false), true); }
typedef int v2i_t __attribute__((ext_vector_type(2)));
typedef unsigned v6u_t __attribute__((ext_vector_type(6)));
DI v6u_t f6x32(const f32x4 a0, const f32x4 a1, const f32x4 a2, const f32x4 a3, const f32x4 b0, const f32x4 b1, const f32x4 b2, const f32x4 b3, const float sdiv) {
    const f32x16 x0 = {a0[0], a0[1], a0[2], a0[3], a1[0], a1[1], a1[2], a1[3], a2[0], a2[1], a2[2], a2[3], a3[0], a3[1], a3[2], a3[3]};
    const f32x16 x1 = {b0[0], b0[1], b0[2], b0[3], b1[0], b1[1], b1[2], b1[3], b2[0], b2[1], b2[2], b2[3], b3[0], b3[1], b3[2], b3[3]};
    return __builtin_amdgcn_cvt_scalef32_2xpk16_fp6_f32(x0, x1, sdiv);
}
#define MFMA8(a, b, c) __builtin_amdgcn_mfma_scale_f32_32x32x64_f8f6f4((a), (b), (c), 0, 0, 0, 0, 0, 0)
DI s16x4 trread(const LAS unsigned char* p) { return __builtin_bit_cast(s16x4, __builtin_amdgcn_ds_read_tr16_b64_v4i16((LAS v4i16_t*)p)); }
DI bf16x8 cat8(s16x4 lo, s16x4 hi) { return (bf16x8){lo[0], lo[1], lo[2], lo[3], hi[0], hi[1], hi[2], hi[3]}; }
template <int S> DI bf16x8 pack8(const f32x16& x) {
    u32x4 p; p.x = pk2(x[8 * S], x[8 * S + 1]); p.y = pk2(x[8 * S + 2], x[8 * S + 3]); p.z = pk2(x[8 * S + 4], x[8 * S + 5]); p.w = pk2(x[8 * S + 6], x[8 * S + 7]);
    return __builtin_bit_cast(bf16x8, p);
}

DI void rope_cs_fast(int pos, int i, float& cs, float& sn) {
    const float x = (float)pos * exp2f(-(float)i * (13.287712379549449f / 32.0f));
    const float k = rintf(x * 0.15915494309189535f);
    float xr = fmaf(-k, 6.28318548202514648f, x); xr = fmaf(-k, -1.74845553e-07f, xr);
    const float t = xr * 0.15915494309189535f;
    cs = __builtin_amdgcn_cosf(t); sn = __builtin_amdgcn_sinf(t);
}
enum { E_SWIGLU = 0, E_RESID = 1, E_WIN = 2, E_BF16 = 3, E_KV = 4, E_RSQ = 5, E_GATEA = 6, E_GATEB = 7, E_QN = 8, E_KVN = 9, E_RESIDN = 10, E_SWIGLUN = 11, E_QKVN = 12, E_GATEAB = 13 };
constexpr int RSC_OFF = 12288;
template <int MODE> struct Epi {
    static constexpr bool PERM = true, AFTER_DRAIN = false, IS_RESIDN = (MODE == E_RESIDN);
    bf16* o0; bf16* o1; bf16* o2; bf16* o3; float* f0; const float* b0; const float* b1; const bf16* g0; const bf16* g1; int ldc; float scale; LAS unsigned char* xch;
    mutable int ord; bf16* an; const float* gn; float* rsp;
    unsigned char* wsb; float* outp;
    DI void operator()(const f32x4 (&acc)[2][2][4][2], const pg8::Unit& u, int wr, int wc, int fr, int fq) const {
        const int rowb = u.pm * 256 + wr * 64 + fr, colb = u.pn * 256 + wc * 32 + 8 * fq;
        if constexpr (MODE == E_QN || MODE == E_KVN || MODE == E_QKVN) {
            const bool isq = (MODE == E_QN) || (MODE == E_QKVN && u.pn < 6);
            const int pmv = (MODE == E_QKVN && !isq) ? u.pm - MT / 256 : u.pm;
            const int pn = (MODE == E_QKVN && !isq) ? u.pn - 6 : u.pn;
            const int rowb2 = pmv * 256 + wr * 64 + fr;
            if (!isq && pn >= 4) {
#pragma unroll
                for (int ai = 0; ai < 2; ++ai)
#pragma unroll
                    for (int m = 0; m < 4; ++m) { const int row = rowb2 + ai * 128 + m * 16; if (row < NP) {
#pragma unroll
                        for (int bj = 0; bj < 2; ++bj) { const f32x4 a = acc[ai][bj][m][0], b = acc[ai][bj][m][1]; u32x4 w; w.x = pk2(a[0], a[1]); w.y = pk2(a[2], a[3]); w.z = pk2(b[0], b[1]); w.w = pk2(b[2], b[3]);
                            *(u32x4*)((bf16*)(wsb + WS_VB) + (size_t)row * DM + (pn - 4) * 256 + wc * 32 + 8 * fq + bj * 128) = w; } } }
                return;
            }
            LAS float* X = (LAS float*)xch; const LAS float* G = (const LAS float*)(xch + 8192);
#pragma unroll
            for (int ai = 0; ai < 2; ++ai)
#pragma unroll
                for (int m = 0; m < 4; ++m)
#pragma unroll
                    for (int bj = 0; bj < 2; ++bj) {
                        const f32x4 a = acc[ai][bj][m][0], b = acc[ai][bj][m][1];
                        float ss = (a[0] * a[0] + a[1] * a[1]) + (a[2] * a[2] + a[3] * a[3]) + (b[0] * b[0] + b[1] * b[1]) + (b[2] * b[2] + b[3] * b[3]);
                        ss += __shfl_xor(ss, 16); ss += __shfl_xor(ss, 32);
                        if (fq == 0) X[((ai * 128 + wr * 64 + m * 16 + fr) * 2 + bj) * 4 + wc] = ss;
                    }
            asm volatile("s_waitcnt lgkmcnt(0)" ::: "memory"); __builtin_amdgcn_s_barrier(); asm volatile("" ::: "memory");
            const bool ropet = isq && pn >= 4;
#pragma unroll
            for (int ai = 0; ai < 2; ++ai)
#pragma unroll
                for (int m = 0; m < 4; ++m) {
                    const int rt = ai * 128 + wr * 64 + m * 16 + fr, row = pmv * 256 + rt; const bool smp = row >= NP;
                    const int pos = smp ? PAST + ((row - NP) & 7) : (row & (SEQ - 1));
#pragma unroll
                    for (int bj = 0; bj < 2; ++bj) {
                        const f32x4 p = *(const LAS f32x4*)(X + (rt * 2 + bj) * 4);
                        const f32x4 a = acc[ai][bj][m][0], b = acc[ai][bj][m][1];
                        if (!ropet) {
                            const int head = 2 * pn + bj, d0 = wc * 32 + 8 * fq;
                            float r = rsqrtf(((p[0] + p[1]) + (p[2] + p[3])) * (1.0f / DN) + EPS);
                            f32x4 g0_, g1_;
                            if (isq) { r *= QSCALE; g0_ = *(const LAS f32x4*)(G + d0); g1_ = *(const LAS f32x4*)(G + d0 + 4);
                                if (smp) { g0_ = g0_ * *(const LAS f32x4*)(G + 192 + d0); g1_ = g1_ * *(const LAS f32x4*)(G + 192 + d0 + 4); } }
                            else { g0_ = *(const LAS f32x4*)(G + 192 + d0); g1_ = *(const LAS f32x4*)(G + 192 + d0 + 4); }
                            const f32x4 y0 = a * r * g0_, y1 = b * r * g1_;
                            u32x4 w; w.x = pk2(y0[0], y0[1]); w.y = pk2(y0[2], y0[3]); w.z = pk2(y1[0], y1[1]); w.w = pk2(y1[2], y1[3]);
                            if (isq) { if (smp) *(u32x4*)((bf16*)(wsb + WS_QN) + (size_t)row * NQ + head * DQ + d0) = w;
                                       else *(u32x2*)(wsb + WS_Q8 + (size_t)row * NQ + head * DQ + d0) = (u32x2){fp8x4(64.f * y0[0], 64.f * y0[1], 64.f * y0[2], 64.f * y0[3]), fp8x4(64.f * y1[0], 64.f * y1[1], 64.f * y1[2], 64.f * y1[3])}; }
                            else if (!smp) *(u32x2*)(wsb + WS_K8 + (size_t)row * NQ + head * DQ + d0) = (u32x2){fp8x4(y0[0], y0[1], y0[2], y0[3]), fp8x4(y1[0], y1[1], y1[2], y1[3])};
                            else if (wc == 0 && fq == 0) ((float*)(wsb + WS_RS))[((size_t)((row - NP) >> 3) * SKEYS + PAST + ((row - NP) & 7)) * NH + head] = r;
                        } else {
                            const int head = 4 * (pn - 4) + 2 * bj + (wc >> 1), i0 = ((wc & 1) * 4 + fq) * 4;
                            const float r = rsqrtf((wc & 2 ? p[2] + p[3] : p[0] + p[1]) * (1.0f / DR) + EPS);
                            const f32x4 g1v = *(const LAS f32x4*)(G + 128 + i0), g2v = *(const LAS f32x4*)(G + 128 + 32 + i0);
                            float o1[4], o2[4];
#pragma unroll
                            for (int j = 0; j < 4; ++j) { float cs, sn; rope_cs_fast(pos, i0 + j, cs, sn); const float y1 = a[j] * r * g1v[j], y2 = b[j] * r * g2v[j];
                                o1[j] = (y1 * cs - y2 * sn) * QSCALE; o2[j] = (y1 * sn + y2 * cs) * QSCALE; }
                            if (smp) { bf16* qp = (bf16*)(wsb + WS_QN) + (size_t)row * NQ + head * DQ + DN + i0;
                                u32x2 w1; w1.x = pk2(o1[0], o1[1]); w1.y = pk2(o1[2], o1[3]); *(u32x2*)qp = w1;
                                u32x2 w2; w2.x = pk2(o2[0], o2[1]); w2.y = pk2(o2[2], o2[3]); *(u32x2*)(qp + 32) = w2; }
                            else { unsigned char* qp = wsb + WS_Q8 + (size_t)row * NQ + head * DQ + DN + i0;
                                *(unsigned*)qp = fp8x4(64.f * o1[0], 64.f * o1[1], 64.f * o1[2], 64.f * o1[3]); *(unsigned*)(qp + 32) = fp8x4(64.f * o2[0], 64.f * o2[1], 64.f * o2[2], 64.f * o2[3]); }
                        }
                    }
                }
            return;
        }
        if constexpr (MODE == E_WIN) {
            const int pn = u.pn; const bool isv = pn >= 6 && pn < 10, normed = pn < 2 || isv;
            float rsc[2][4];
#pragma unroll
            for (int ai = 0; ai < 2; ++ai)
#pragma unroll
                for (int m = 0; m < 4; ++m) rsc[ai][m] = *(const LAS float*)(xch + RSC_OFF + (ord * 256 + ai * 128 + wr * 64 + m * 16 + fr) * 4);
            ++ord;
            if (!normed) {
                const int sec = (pn - 2) >> 2;
                bf16* ob0 = (bf16*)(wsb + (sec == 0 ? WS_U : sec == 2 ? WS_GA : WS_GG));
                const int c0 = colb - 512 - sec * 1024;
#pragma unroll
                for (int ai = 0; ai < 2; ++ai)
#pragma unroll
                    for (int m = 0; m < 4; ++m)
#pragma unroll
                        for (int bj = 0; bj < 2; ++bj) {
                            f32x4 a = acc[ai][bj][m][0] * rsc[ai][m], b = acc[ai][bj][m][1] * rsc[ai][m];
                            if (sec == 0) { const f32x2 g0_ = pg8::gelu_pk((f32x2){a[0], a[1]}), g1_ = pg8::gelu_pk((f32x2){a[2], a[3]}), g2_ = pg8::gelu_pk((f32x2){b[0], b[1]}), g3_ = pg8::gelu_pk((f32x2){b[2], b[3]});
                                a = (f32x4){g0_.x, g0_.y, g1_.x, g1_.y}; b = (f32x4){g2_.x, g2_.y, g3_.x, g3_.y}; }
                            else {
#pragma unroll
                                for (int j = 0; j < 4; ++j) { a[j] = sigmoidf_(a[j]); b[j] = sigmoidf_(b[j]); } }
                            u32x4 w; w.x = pk2(a[0], a[1]); w.y = pk2(a[2], a[3]); w.z = pk2(b[0], b[1]); w.w = pk2(b[2], b[3]);
                            *(u32x4*)(ob0 + (size_t)(rowb + ai * 128 + m * 16) * DM + c0 + bj * 128) = w;
                        }
                return;
            }
            LAS float* X = (LAS float*)xch; const LAS float* G = (const LAS float*)(xch + 4096) + (pn < 2 ? pn * 256 : 512 + (pn - 6) * 256);
            f32x4 (&W_)[2][2][4][2] = const_cast<f32x4 (&)[2][2][4][2]>(acc);
#pragma unroll
            for (int ai = 0; ai < 2; ++ai)
#pragma unroll
                for (int m = 0; m < 4; ++m) {
                    float ss = 0.f;
#pragma unroll
                    for (int bj = 0; bj < 2; ++bj) {
                        f32x4 a = acc[ai][bj][m][0] * rsc[ai][m], b = acc[ai][bj][m][1] * rsc[ai][m];
                        if (isv) { const f32x2 g0_ = pg8::gelu_pk((f32x2){a[0], a[1]}), g1_ = pg8::gelu_pk((f32x2){a[2], a[3]}), g2_ = pg8::gelu_pk((f32x2){b[0], b[1]}), g3_ = pg8::gelu_pk((f32x2){b[2], b[3]});
                            a = (f32x4){g0_.x, g0_.y, g1_.x, g1_.y}; b = (f32x4){g2_.x, g2_.y, g3_.x, g3_.y}; }
                        W_[ai][bj][m][0] = a; W_[ai][bj][m][1] = b;
                        ss += (a[0] * a[0] + a[1] * a[1]) + (a[2] * a[2] + a[3] * a[3]) + (b[0] * b[0] + b[1] * b[1]) + (b[2] * b[2] + b[3] * b[3]);
                    }
                    ss += __shfl_xor(ss, 16); ss += __shfl_xor(ss, 32);
                    if (fq == 0) X[(ai * 128 + wr * 64 + m * 16 + fr) * 4 + wc] = ss;
                }
            asm volatile("s_waitcnt lgkmcnt(0)" ::: "memory"); __builtin_amdgcn_s_barrier(); asm volatile("" ::: "memory");
            const int cl = wc * 32 + 8 * fq;
#pragma unroll
            for (int ai = 0; ai < 2; ++ai)
#pragma unroll
                for (int m = 0; m < 4; ++m) {
                    const int rt = ai * 128 + wr * 64 + m * 16 + fr, row = u.pm * 256 + rt;
                    const f32x4 p = *(const LAS f32x4*)(X + rt * 4);
                    const float r = rsqrtf(((p[0] + p[1]) + (p[2] + p[3])) * (1.0f / 256.0f) + EPS);
#pragma unroll
                    for (int bj = 0; bj < 2; ++bj) {
                        const int c = cl + bj * 128;
                        const f32x4 g0_ = *(const LAS f32x4*)(G + c), g1_ = *(const LAS f32x4*)(G + c + 4);
                        const f32x4 y0 = W_[ai][bj][m][0] * r * g0_, y1 = W_[ai][bj][m][1] * r * g1_;
                        u32x4 w; w.x = pk2(y0[0], y0[1]); w.y = pk2(y0[2], y0[3]); w.z = pk2(y1[0], y1[1]); w.w = pk2(y1[2], y1[3]);
                        if (pn == 0) *(u32x4*)((bf16*)(wsb + WS_CQN) + (size_t)row * RL + c) = w;
                        else if (pn == 1) {
                            *(u32x4*)((bf16*)(wsb + WS_LATB) + (size_t)row * RL + c) = w;
                            float* op = (row < NP ? outp + OUT_LATP + (size_t)row * RL : outp + OUT_LATS + (size_t)(row - NP) * RL) + c;
                            *(f32x4*)op = y0; *(f32x4*)(op + 4) = y1;
                        } else {
                            *(u32x4*)((bf16*)(wsb + WS_VG) + (size_t)row * DM + (pn - 6) * 256 + c) = w;
                            if (row >= NP) { float* op = outp + OUT_VS + (size_t)(row - NP) * DM + (pn - 6) * 256 + c; *(f32x4*)op = y0; *(f32x4*)(op + 4) = y1; }
                        }
                    }
                }
            return;
        }
        if constexpr (MODE == E_RSQ) {
            LAS float* X = (LAS float*)xch;
#pragma unroll
            for (int ai = 0; ai < 2; ++ai)
#pragma unroll
                for (int m = 0; m < 4; ++m)
#pragma unroll
                    for (int bj = 0; bj < 2; ++bj) {
                        const f32x4 a = acc[ai][bj][m][0], b = acc[ai][bj][m][1];
                        float ss = (a[0] * a[0] + a[1] * a[1]) + (a[2] * a[2] + a[3] * a[3]) + (b[0] * b[0] + b[1] * b[1]) + (b[2] * b[2] + b[3] * b[3]);
                        ss += __shfl_xor(ss, 16); ss += __shfl_xor(ss, 32);
                        if (fq == 0) X[(ai * 128 + wr * 64 + m * 16 + fr) * 8 + bj * 4 + wc] = ss;
                    }
            asm volatile("s_waitcnt lgkmcnt(0)" ::: "memory"); __builtin_amdgcn_s_barrier(); asm volatile("" ::: "memory");
            const int tid = threadIdx.x, rt = tid >> 1, hd = tid & 1;
            const f32x4 p = *(const LAS f32x4*)(X + rt * 8 + hd * 4);
            const float s = (p[0] + p[1]) + (p[2] + p[3]);
            f0[(size_t)(u.pm * 256 + rt) * 8 + u.pn * 2 + hd] = rsqrtf(s * (1.0f / 128.0f) + EPS);
            return;
        }
#pragma unroll
        for (int ai = 0; ai < 2; ++ai)
#pragma unroll
            for (int m = 0; m < 4; ++m) {
                const int row = rowb + ai * 128 + m * 16;
                const float rs = (MODE == E_SWIGLUN) ? *(const LAS float*)(xch + RSC_OFF + (ord * 256 + ai * 128 + wr * 64 + m * 16 + fr) * 4) : 1.0f;
                float ss = 0.f;
#pragma unroll
                for (int bj = 0; bj < 2; ++bj) ss += store8(row, colb + bj * 128, u.pn, acc[ai][bj][m][0] * rs, acc[ai][bj][m][1] * rs);
                if constexpr (MODE == E_RESIDN) { ss += __shfl_xor(ss, 16); ss += __shfl_xor(ss, 32); if (fq == 0) rsp[(size_t)row * 16 + u.pn * 4 + wc] = ss; }
            }
        if constexpr (MODE == E_SWIGLUN) ++ord;
    }
    DI float store8(int row, int col, int pn, const f32x4 v0, const f32x4 v1) const {
                    if constexpr (MODE == E_SWIGLU || MODE == E_SWIGLUN) {
                        u32x2 w; float h[4];
#pragma unroll
                        for (int j = 0; j < 4; ++j) h[j] = v0[j] * sigmoidf_(v0[j]) * v1[j];
                        w.x = pk2(h[0], h[1]); w.y = pk2(h[2], h[3]);
                        *(u32x2*)(o0 + (size_t)row * ldc + (col >> 1)) = w;
                    } else if constexpr (MODE == E_RESID) {
                        const float* bp = (row < NP ? b0 + (size_t)row * DM : b1 + (size_t)(row - NP) * DM) + col;
                        float* op = f0 + (size_t)row * DM + col;
                        const f32x4 x0 = *(const f32x4*)bp, x1 = *(const f32x4*)(bp + 4);
                        *(f32x4*)op = x0 + v0 * scale; *(f32x4*)(op + 4) = x1 + v1 * scale;
                    } else if constexpr (MODE == E_RESIDN) {
                        const float* bp = (row < NP ? b0 + (size_t)row * DM : b1 + (size_t)(row - NP) * DM) + col;
                        float* op = f0 + (size_t)row * DM + col;
                        const f32x4 x0 = *(const f32x4*)bp, x1 = *(const f32x4*)(bp + 4);
                        const f32x4 y0 = x0 + v0 * scale, y1 = x1 + v1 * scale;
                        *(f32x4*)op = y0; *(f32x4*)(op + 4) = y1;
                        const f32x4 g0_ = *(const f32x4*)(gn + col), g1_ = *(const f32x4*)(gn + col + 4);
                        u32x4 w; w.x = pk2(y0[0] * g0_[0], y0[1] * g0_[1]); w.y = pk2(y0[2] * g0_[2], y0[3] * g0_[3]); w.z = pk2(y1[0] * g1_[0], y1[1] * g1_[1]); w.w = pk2(y1[2] * g1_[2], y1[3] * g1_[3]);
                        *(u32x4*)(an + (size_t)row * DM + col) = w;
                        return (y0[0] * y0[0] + y0[1] * y0[1]) + (y0[2] * y0[2] + y0[3] * y0[3]) + (y1[0] * y1[0] + y1[1] * y1[1]) + (y1[2] * y1[2] + y1[3] * y1[3]);
                    } else if constexpr (MODE == E_WIN) {
                        if (pn < 3) {
                            float* op = f0 + (size_t)row * NSM + col;
                            *(f32x4*)op = v0; *(f32x4*)(op + 4) = v1;
                        } else {
                            const int sec = (pn - 3) >> 2, c = col - 768 - sec * 1024;
                            bf16* ob = (sec == 0 ? o0 : sec == 1 ? o1 : sec == 2 ? o2 : o3) + (size_t)row * DM + c;
                            f32x4 a = v0, b = v1;
                            if (sec < 2) {
                                const f32x2 g0_ = pg8::gelu_pk((f32x2){a[0], a[1]}), g1_ = pg8::gelu_pk((f32x2){a[2], a[3]}), g2_ = pg8::gelu_pk((f32x2){b[0], b[1]}), g3_ = pg8::gelu_pk((f32x2){b[2], b[3]});
                                a = (f32x4){g0_.x, g0_.y, g1_.x, g1_.y}; b = (f32x4){g2_.x, g2_.y, g3_.x, g3_.y};
                            } else {
#pragma unroll
                                for (int j = 0; j < 4; ++j) { a[j] = sigmoidf_(a[j]); b[j] = sigmoidf_(b[j]); }
                            }
                            u32x4 w; w.x = pk2(a[0], a[1]); w.y = pk2(a[2], a[3]); w.z = pk2(b[0], b[1]); w.w = pk2(b[2], b[3]);
                            *(u32x4*)ob = w;
                        }
                    } else if constexpr (MODE == E_BF16) {
                        u32x4 w; w.x = pk2(v0[0], v0[1]); w.y = pk2(v0[2], v0[3]); w.z = pk2(v1[0], v1[1]); w.w = pk2(v1[2], v1[3]);
                        *(u32x4*)(o0 + (size_t)row * ldc + col) = w;
                    } else if constexpr (MODE == E_KV) {
                        u32x4 w; w.x = pk2(v0[0], v0[1]); w.y = pk2(v0[2], v0[3]); w.z = pk2(v1[0], v1[1]); w.w = pk2(v1[2], v1[3]);
                        bf16* ob = (pn < 4 ? o0 + col : o1 + (col - 1024)) + (size_t)row * DM;
                        *(u32x4*)ob = w;
                    } else if constexpr (MODE == E_GATEAB) {
                        if (pn < 4) {
                            const u32x4 g = *(const u32x4*)(g0 + (size_t)row * DM + col);
                            float* op = f0 + (size_t)row * DM + col;
                            *(f32x4*)op = (f32x4){v0[0] * bflo(g.x), v0[1] * bfhi(g.x), v0[2] * bflo(g.y), v0[3] * bfhi(g.y)};
                            *(f32x4*)(op + 4) = (f32x4){v1[0] * bflo(g.z), v1[1] * bfhi(g.z), v1[2] * bflo(g.w), v1[3] * bfhi(g.w)};
                        } else {
                            const int r2 = row - MT, c2 = col - 1024;
                            const u32x4 g = *(const u32x4*)(g1 + (size_t)r2 * DM + c2);
                            const float* mp = f0 + (size_t)r2 * DM + c2;
                            const f32x4 m0 = *(const f32x4*)mp, m1_ = *(const f32x4*)(mp + 4);
                            u32x4 w;
                            w.x = pk2(m0[0] + v0[0] * bflo(g.x), m0[1] + v0[1] * bfhi(g.x)); w.y = pk2(m0[2] + v0[2] * bflo(g.y), m0[3] + v0[3] * bfhi(g.y));
                            w.z = pk2(m1_[0] + v1[0] * bflo(g.z), m1_[1] + v1[1] * bfhi(g.z)); w.w = pk2(m1_[2] + v1[2] * bflo(g.w), m1_[3] + v1[3] * bfhi(g.w));
                            *(u32x4*)(o0 + (size_t)r2 * DM + c2) = w;
                        }
                    } else if constexpr (MODE == E_GATEA) {
                        const u32x4 g = *(const u32x4*)(g0 + (size_t)row * DM + col);
                        float* op = f0 + (size_t)row * DM + col;
                        *(f32x4*)op = (f32x4){v0[0] * bflo(g.x), v0[1] * bfhi(g.x), v0[2] * bflo(g.y), v0[3] * bfhi(g.y)};
                        *(f32x4*)(op + 4) = (f32x4){v1[0] * bflo(g.z), v1[1] * bfhi(g.z), v1[2] * bflo(g.w), v1[3] * bfhi(g.w)};
                    } else if constexpr (MODE == E_GATEB) {
                        const u32x4 g = *(const u32x4*)(g0 + (size_t)row * DM + col);
                        const float* mp = f0 + (size_t)row * DM + col;
                        const f32x4 m0 = *(const f32x4*)mp, m1 = *(const f32x4*)(mp + 4);
                        u32x4 w;
                        w.x = pk2(m0[0] + v0[0] * bflo(g.x), m0[1] + v0[1] * bfhi(g.x)); w.y = pk2(m0[2] + v0[2] * bflo(g.y), m0[3] + v0[3] * bfhi(g.y));
                        w.z = pk2(m1[0] + v1[0] * bflo(g.z), m1[1] + v1[1] * bfhi(g.z)); w.w = pk2(m1[2] + v1[2] * bflo(g.w), m1[3] + v1[3] * bfhi(g.w));
                        *(u32x4*)(o0 + (size_t)row * DM + col) = w;
                    }
        return 0.f;
    }
};

struct Args { const void* in[30]; float* out; unsigned char* ws; };
struct Ctx {
    LAS unsigned char* lds; int tid, lane, wave, vcu, G;
    const Args* a;
};

DI int dest_row(int mode, int n) {
    if (mode == 5) { const int head = n / DQ, d = n - head * DQ; if (d < DN) return head * DN + d; const int q = d - DN, half = q >> 5, i = q & 31; return 1024 + head * 64 + 8 * (i >> 2) + 4 * half + (i & 3); }
    return mode == 0 ? n : mode == 1 ? 8 * (n >> 2) + (n & 3) : mode == 2 ? 8 * (n >> 2) + 4 + (n & 3) : mode == 3 ? (n < 512 ? n : n < 576 ? 4608 + (n - 512) : n - 64) : n + 1024;
}
DI void p0_transpose_item(const float* W, int K, int N, bf16* WT, int mode, LAS float* scr, int item, int lane) {
    const int nblk = N / 32, kb = item / nblk, nb = item % nblk, k0 = 64 * kb, n0 = 32 * nb;
#pragma unroll 8
    for (int i = 0; i < 32; ++i) { const int kk = 2 * i + (lane >> 5); scr[kk * 33 + (lane & 31)] = W[(size_t)(k0 + kk) * N + n0 + (lane & 31)]; }
    asm volatile("s_waitcnt lgkmcnt(0)" ::: "memory");
    const int c = lane & 7;
#pragma unroll
    for (int j = 0; j < 4; ++j) { const int n = (lane >> 3) + 8 * j; const LAS float* s = scr + (8 * c) * 33 + n;
        v4u o; o.x = pk2(s[0 * 33], s[1 * 33]); o.y = pk2(s[2 * 33], s[3 * 33]); o.z = pk2(s[4 * 33], s[5 * 33]); o.w = pk2(s[6 * 33], s[7 * 33]);
        *(v4u*)(WT + (size_t)dest_row(mode, n0 + n) * K + k0 + 8 * c) = o; }
    asm volatile("s_waitcnt lgkmcnt(0)" ::: "memory");
}
DI void rms_row_1024(const float* xrow, const float* g, bf16* orow, int lane) {
    const f32x4* xr = (const f32x4*)xrow + lane; const f32x4* gr = (const f32x4*)g + lane;
    f32x4 v[4]; float s = 0.f;
#pragma unroll
    for (int j = 0; j < 4; ++j) { v[j] = xr[64 * j]; s += (v[j][0] * v[j][0] + v[j][1] * v[j][1]) + (v[j][2] * v[j][2] + v[j][3] * v[j][3]); }
    const float r = rsqrtf(wave_sum(s) * (1.f / DM) + EPS);
    u32x2* o8 = (u32x2*)orow + lane;
#pragma unroll
    for (int j = 0; j < 4; ++j) { const f32x4 gg = gr[64 * j]; u32x2 w; w.x = pk2(v[j][0] * r * gg[0], v[j][1] * r * gg[1]); w.y = pk2(v[j][2] * r * gg[2], v[j][3] * r * gg[3]); o8[64 * j] = w; }
}
DI void p0_prologue(const Ctx& C) {
    const Args& A = *C.a; unsigned char* ws = A.ws; int tid_ = threadIdx.x; asm volatile("" : "+v"(tid_)); const int lane = tid_ & 63;
    LAS float* scr = (LAS float*)(C.lds + C.wave * 16384);
    const int gw = C.vcu * NWAVES + C.wave, NGW = C.G * NWAVES;
    constexpr int I_G = (DM / 64) * (DFF / 32), I_D = (DFF / 64) * (DM / 32), I_IN = (DM / 64) * (4672 / 32), I_UQ = (RL / 64) * (NQ / 32), I_UK = (RL / 64) * (1024 / 32), I_SQ = (DM / 64) * (DM / 32);
    constexpr int NITEMS = 4 * I_G + 2 * I_D + I_IN + I_UQ + 2 * I_UK + 3 * I_SQ;
    for (int it = gw; it < NITEMS; it += NGW) {
        int r = it;
#define TR_(idx, K_, N_, off, mode, NI) if (r < (NI)) { p0_transpose_item((const float*)A.in[idx], K_, N_, (bf16*)(ws + (off)), mode, scr, r, lane); continue; } r -= (NI);
        TR_(6, DM, DFF, WS_W1GU, 1, I_G)
        TR_(7, DM, DFF, WS_W1GU, 2, I_G)
        TR_(8, DFF, DM, WS_W1D, 0, I_D)
        TR_(27, DM, DFF, WS_W2GU, 1, I_G)
        TR_(28, DM, DFF, WS_W2GU, 2, I_G)
        TR_(29, DFF, DM, WS_W2D, 0, I_D)
        TR_(10, DM, 4672, WS_WIN, 3, I_IN)
        TR_(12, RL, NQ, WS_WUQ, 5, I_UQ)
        TR_(14, RL, 1024, WS_WUKV, 0, I_UK)
        TR_(15, RL, 1024, WS_WUKV, 4, I_UK)
        TR_(23, DM, DM, WS_WOA, 0, I_SQ)
        TR_(24, DM, DM, WS_WOG, 0, I_SQ)
        TR_(25, DM, DM, WS_WOUT, 0, I_SQ)
#undef TR_
    }
    const int gt = gw * 64 + lane, NGT = NGW * 64;
    {
        const float* wuk = (const float*)A.in[14]; v4u* o = (v4u*)(ws + WS_WUKO);
        for (int i = gt; i < 8 * 8 * 8 * 64; i += NGT) {
            const int ln = i & 63, s2 = (i >> 6) & 7, jb = (i >> 9) & 7, h = i >> 12;
            const float* q = wuk + (size_t)(32 * jb + (ln & 31)) * 1024 + 128 * h + 16 * s2 + 8 * (ln >> 5);
            const f32x4 v0 = *(const f32x4*)q, v1 = *(const f32x4*)(q + 4);
            o[i] = (v4u){pk2(v0[0], v0[1]), pk2(v0[2], v0[3]), pk2(v1[0], v1[1]), pk2(v1[2], v1[3])};
        }
    }
    { const float* wsrc = (const float*)A.in[21]; bf16* o = (bf16*)(ws + WS_WST);
      for (int i = gt; i < 4 * 128 * 128; i += NGT) { const int t = (i >> 7) & 127, s = i & 127; o[i] = (bf16)f2bf(s <= t ? wsrc[i] : 0.f); } }
    {
        const float* wuk = (const float*)A.in[14]; unsigned char* wf = ws + WS_WF;
        for (int i = gt; i < 8 * 4 * 4 * 64; i += NGT) {
            const int ln = i & 63, s = (i >> 6) & 3, db = (i >> 8) & 3, h = i >> 10;
            const int g = 2 * s + (ln >> 5);
            const float* q = wuk + (size_t)(8 * g) * 1024 + h * 128 + 32 * db + (ln & 31);
            f32x4 ra[4], rb[4];
#pragma unroll
            for (int k = 0; k < 4; ++k)
#pragma unroll
                for (int b = 0; b < 4; ++b) { ra[k][b] = q[(size_t)(64 * k + b) * 1024]; rb[k][b] = q[(size_t)(64 * k + 4 + b) * 1024]; }
            const v6u_t o = f6x32(ra[0], ra[1], ra[2], ra[3], rb[0], rb[1], rb[2], rb[3], 1.f / 32.f);
            unsigned char* fb = wf + (size_t)(i >> 6) * 1536;
            *(v4u*)(fb + ln * 16) = (v4u){o[0], o[1], o[2], o[3]};
            *(u32x2*)(fb + 1024 + ln * 8) = (u32x2){o[4], o[5]};
        }
    }
    for (int m = gw; m < MT; m += NGW) {
        const float* xr = m < NP ? (const float*)A.in[0] + (size_t)m * DM : (const float*)A.in[1] + (size_t)(m - NP) * DM;
        rms_row_1024(xr, (const float*)A.in[5], (bf16*)(ws + WS_A) + (size_t)m * DM, lane);
    }
}

template <class EpiT> DI void gemm_small(const Ctx& C, const bf16* A, const bf16* Bt, int N, int K, const EpiT& E) {
    LAS float* red = (LAS float*)C.lds;
    int tid_ = threadIdx.x; asm volatile("" : "+v"(tid_)); const int tid = tid_, lane = tid & 63, wid = C.wave, n = lane & 31, hh = lane >> 5;
    const int ntn = N >> 6, nitems = (NS >> 6) * ntn, kw = K >> 3, nch = kw >> 5;
    LAS unsigned char* stg = C.lds + wid * 16384;
    const int drow = lane >> 2, dc = (lane & 3) ^ ((drow >> 2) & 3);
    const int roff = (n >> 4) * 1024 + (n & 15) * 64, rx = (n >> 2) & 3;
    const size_t rstep = (size_t)16 * K * 2;
    for (int it = C.vcu; it < nitems; it += C.G) {
        const int tm = it / ntn, tn = it - tm * ntn, row0 = NP + tm * 64, col0 = tn * 64;
        __syncthreads();
        f32x16 acc[2][2];
#pragma unroll
        for (int i = 0; i < 2; ++i)
#pragma unroll
            for (int j = 0; j < 2; ++j)
#pragma unroll
                for (int r = 0; r < 16; ++r) acc[i][j][r] = 0.f;
        const char* ag = (const char*)(A + (size_t)(row0 + drow) * K + wid * kw) + dc * 16; const char* bg = (const char*)(Bt + (size_t)(col0 + drow) * K + wid * kw) + dc * 16;
#define GS_STAGE(buf_, ch_) do { _Pragma("unroll") for (int j = 0; j < 4; ++j) { \
            __builtin_amdgcn_global_load_lds((const unsigned*)(ag + j * rstep + (size_t)(ch_) * 64), (LAS unsigned*)(stg + (buf_) * 8192 + j * 1024), 16, 0, 0); \
            __builtin_amdgcn_global_load_lds((const unsigned*)(bg + j * rstep + (size_t)(ch_) * 64), (LAS unsigned*)(stg + (buf_) * 8192 + 4096 + j * 1024), 16, 0, 0); } } while (0)
        GS_STAGE(0, 0);
#pragma nounroll
        for (int ch = 0; ch < nch; ++ch) {
            if (ch + 1 < nch) { GS_STAGE((ch + 1) & 1, ch + 1); asm volatile("s_waitcnt vmcnt(8)" ::: "memory"); }
            else asm volatile("s_waitcnt vmcnt(0)" ::: "memory");
            const LAS unsigned char* sb = stg + (ch & 1) * 8192 + roff;
            bf16x8 a[2][2], b[2][2];
#pragma unroll
            for (int i = 0; i < 2; ++i)
#pragma unroll
                for (int t = 0; t < 2; ++t) { a[i][t] = *(const LAS bf16x8*)(sb + i * 2048 + (((2 * t + hh) ^ rx) * 16)); b[i][t] = *(const LAS bf16x8*)(sb + 4096 + i * 2048 + (((2 * t + hh) ^ rx) * 16)); }
#pragma unroll
            for (int t = 0; t < 2; ++t) { acc[0][0] = MFMA32(a[0][t], b[0][t], acc[0][0]); acc[0][1] = MFMA32(a[0][t], b[1][t], acc[0][1]); acc[1][0] = MFMA32(a[1][t], b[0][t], acc[1][0]); acc[1][1] = MFMA32(a[1][t], b[1][t], acc[1][1]); }
            asm volatile("s_waitcnt lgkmcnt(0)" ::: "memory");
            __builtin_amdgcn_sched_barrier(0);
        }
#undef GS_STAGE
#pragma unroll
        for (int i = 0; i < 2; ++i)
#pragma unroll
            for (int j = 0; j < 2; ++j)
#pragma unroll
                for (int r = 0; r < 16; ++r) red[wid * 4096 + (32 * i + crow(r, hh)) * 64 + 32 * j + n] = acc[i][j][r];
        __syncthreads();
        const int row = tid >> 3, c8 = (tid & 7) * 8;
        f32x4 v0 = {0.f, 0.f, 0.f, 0.f}, v1 = {0.f, 0.f, 0.f, 0.f};
#pragma unroll
        for (int w = 0; w < 8; ++w) { v0 += *(const LAS f32x4*)(red + w * 4096 + row * 64 + c8); v1 += *(const LAS f32x4*)(red + w * 4096 + row * 64 + c8 + 4); }
        { const float ss = E.store8(row0 + row, col0 + c8, (col0 + c8) >> 8, v0, v1); if constexpr (EpiT::IS_RESIDN) E.rsp[(size_t)NP * 16 + (size_t)(row0 + row - NP) * 128 + tn * 8 + (tid & 7)] = ss; }
    }
    __syncthreads();
}

template <class Sched> DI void fill_rowscale(const Ctx& C, const Sched& S, const float* rsp) {
    int tid_ = threadIdx.x; asm volatile("" : "+v"(tid_)); const int tid = tid_;
    pg8::Unit uu;
    for (int i = 0; i < 8 && S.next(i, uu); ++i) {
        if (tid < 256) {
            const int row = uu.pm * 256 + tid; float ss = 0.f;
            if (row < NP) { const f32x4* p = (const f32x4*)(rsp + (size_t)row * 16);
#pragma unroll
                for (int k = 0; k < 4; ++k) { const f32x4 v = p[k]; ss += (v[0] + v[1]) + (v[2] + v[3]); } }
            else { const f32x4* p = (const f32x4*)(rsp + (size_t)NP * 16 + (size_t)(row - NP) * 128);
#pragma unroll 8
                for (int k = 0; k < 32; ++k) { const f32x4 v = p[k]; ss += (v[0] + v[1]) + (v[2] + v[3]); } }
            *(LAS float*)(C.lds + XCH_OFF + RSC_OFF + (i * 256 + tid) * 4) = rsqrtf(ss * (1.0f / DM) + EPS);
        }
    }
    __syncthreads();
}

DI void rope_angle(int pos, int i, float& cs, float& sn) {
    const float inv = exp2f(-(float)i * (13.287712379549449f / 32.0f));
    const float ang = (float)pos * inv; cs = cosf(ang); sn = sinf(ang);
}
DI void krope_gemm(const Ctx& C) {
    const Args& A_ = *C.a; unsigned char* ws = A_.ws; LAS float* red = (LAS float*)C.lds;
    int tid_ = threadIdx.x; asm volatile("" : "+v"(tid_)); const int tid = tid_, lane = tid & 63, wid = C.wave, n = lane & 31, hh = lane >> 5;
    const bf16* A = (const bf16*)(ws + WS_A); const bf16* Bt = (const bf16*)(ws + WS_WIN) + (size_t)4608 * DM; bf16* KRB = (bf16*)(ws + WS_KRB);
    const float* gkr = (const float*)A_.in[19];
    constexpr int K = DM, kw = K >> 3, nks = kw >> 4;
    static_assert(MT % 68 == 0 && MT / 68 == 256, "k_rope items: 68 rows each, one per workgroup");
    for (int it = C.vcu; it < MT / 68; it += C.G) {
        const int row0 = it * 68;
        f32x16 acc[3][2];
#pragma unroll
        for (int i = 0; i < 3; ++i)
#pragma unroll
            for (int j = 0; j < 2; ++j)
#pragma unroll
                for (int r = 0; r < 16; ++r) acc[i][j][r] = 0.f;
        const bf16* ap = A + (size_t)(row0 + n) * K + wid * kw + 8 * hh; const bf16* bp = Bt + (size_t)n * K + wid * kw + 8 * hh;
        const int r2 = row0 + 64 + n < MT ? row0 + 64 + n : MT - 1; const bf16* ap2 = A + (size_t)r2 * K + wid * kw + 8 * hh;
        const size_t blk = (size_t)32 * K;
#pragma unroll 8
        for (int s = 0; s < nks; ++s) {
            const bf16x8 a0 = *(const bf16x8*)(ap + 16 * s), a1 = *(const bf16x8*)(ap + blk + 16 * s), a2 = *(const bf16x8*)(ap2 + 16 * s), b0 = *(const bf16x8*)(bp + 16 * s), b1 = *(const bf16x8*)(bp + blk + 16 * s);
            acc[0][0] = MFMA32(a0, b0, acc[0][0]); acc[0][1] = MFMA32(a0, b1, acc[0][1]); acc[1][0] = MFMA32(a1, b0, acc[1][0]); acc[1][1] = MFMA32(a1, b1, acc[1][1]);
            acc[2][0] = MFMA32(a2, b0, acc[2][0]); acc[2][1] = MFMA32(a2, b1, acc[2][1]);
        }
        __syncthreads();
#pragma unroll
        for (int i = 0; i < 3; ++i)
#pragma unroll
            for (int j = 0; j < 2; ++j)
#pragma unroll
                for (int r = 0; r < 16; ++r) { const int rr = 32 * i + crow(r, hh); if (rr < 68) red[wid * 4352 + rr * 64 + 32 * j + n] = acc[i][j][r]; }
        __syncthreads();
        for (int rl = tid >> 3; rl < 68; rl += 64) {
        const int c8 = tid & 7, row = row0 + rl;
        f32x4 v0 = {0.f, 0.f, 0.f, 0.f}, v1 = {0.f, 0.f, 0.f, 0.f};
#pragma unroll
        for (int w = 0; w < 8; ++w) { v0 += *(const LAS f32x4*)(red + w * 4352 + rl * 64 + c8 * 8); v1 += *(const LAS f32x4*)(red + w * 4352 + rl * 64 + c8 * 8 + 4); }
        const bool smp = row >= NP;
        {
            const float* rsp = (const float*)(ws + WS_RSP); float ps;
            if (!smp) { const f32x2 p = *(const f32x2*)(rsp + (size_t)row * 16 + c8 * 2); ps = p[0] + p[1]; }
            else { const f32x4* p = (const f32x4*)(rsp + (size_t)NP * 16 + (size_t)(row - NP) * 128 + c8 * 16); ps = 0.f;
#pragma unroll
                for (int k = 0; k < 4; ++k) { const f32x4 q = p[k]; ps += (q[0] + q[1]) + (q[2] + q[3]); } }
            ps += __shfl_xor(ps, 1); ps += __shfl_xor(ps, 2); ps += __shfl_xor(ps, 4);
            const float rx = rsqrtf(ps * (1.0f / DM) + EPS);
            v0 = v0 * rx; v1 = v1 * rx;
        }
        float ss = (v0[0] * v0[0] + v0[1] * v0[1]) + (v0[2] * v0[2] + v0[3] * v0[3]) + (v1[0] * v1[0] + v1[1] * v1[1]) + (v1[2] * v1[2] + v1[3] * v1[3]);
        ss += __shfl_xor(ss, 1); ss += __shfl_xor(ss, 2); ss += __shfl_xor(ss, 4);
        const float r = rsqrtf(ss * (1.0f / DR) + EPS); const int pos = smp ? PAST + ((row - NP) & 7) : (row & (SEQ - 1));
        float y[8], o[8];
#pragma unroll
        for (int j = 0; j < 8; ++j) y[j] = (j < 4 ? v0[j] : v1[j - 4]) * r * gkr[c8 * 8 + j];
#pragma unroll
        for (int j = 0; j < 8; ++j) {
            const float yo = __shfl_xor(y[j], 4);
            float cs, sn; rope_cs_fast(pos, (c8 & 3) * 8 + j, cs, sn);
            o[j] = c8 < 4 ? y[j] * cs - yo * sn : yo * sn + y[j] * cs;
        }
        float* op = (smp ? A_.out + OUT_ROPES + (size_t)(row - NP) * DR : A_.out + OUT_ROPEP + (size_t)row * DR) + c8 * 8;
        *(f32x4*)op = (f32x4){o[0], o[1], o[2], o[3]}; *(f32x4*)(op + 4) = (f32x4){o[4], o[5], o[6], o[7]};
        u32x4 w; w.x = pk2(o[0], o[1]); w.y = pk2(o[2], o[3]); w.z = pk2(o[4], o[5]); w.w = pk2(o[6], o[7]);
        *(u32x4*)(KRB + (size_t)row * DR + c8 * 8) = w;
        if (!smp) { unsigned char* kp = ws + WS_K8 + (size_t)row * NQ + DN + c8 * 8; const u32x2 w8 = (u32x2){fp8x4(o[0], o[1], o[2], o[3]), fp8x4(o[4], o[5], o[6], o[7])};
#pragma unroll
            for (int h = 0; h < NH; ++h) *(u32x2*)(kp + h * DQ) = w8; }
        }
    }
    __syncthreads();
}

DI void p3_norm_rows(const Ctx& C, const float* X, const float* g, bf16* Aout) {
    const int gw = C.vcu * NWAVES + C.wave, NGW = C.G * NWAVES;
    int tid_ = threadIdx.x; asm volatile("" : "+v"(tid_)); const int lane = tid_ & 63;
    for (int m = gw; m < MT; m += NGW) rms_row_1024(X + (size_t)m * DM, g, Aout + (size_t)m * DM, lane);
}

constexpr float SM_SHIFT = 10.0f;
constexpr int PK_PITCH = 400, PV_PITCH = 288, PKB = 64 * PK_PITCH, PVB = 64 * PV_PITCH;
constexpr int PK8_PITCH = 208, PK8B = 64 * PK8_PITCH;
DI void attn_prompt_unit(const Ctx& C, const unsigned char* Q8, const unsigned char* K8, const bf16* VB, bf16* ATT, int b, int h, int qb) {
    LAS unsigned char* lds = C.lds; int tid_ = threadIdx.x; asm volatile("" : "+v"(tid_)); const int tid = tid_, lane = tid & 63, wid = C.wave, n = lane & 31, hi = lane >> 5;
    const size_t row0 = (size_t)b * SEQ; const int qrow = qb * 256 + wid * 32 + n;
    v8i_t qf[3];
    { const unsigned char* qp = Q8 + (row0 + qrow) * NQ + h * DQ + 32 * hi;
#pragma unroll
      for (int s = 0; s < 3; ++s) qf[s] = __builtin_shufflevector(*(const v4i_t*)(qp + 64 * s), *(const v4i_t*)(qp + 64 * s + 16), 0, 1, 2, 3, 4, 5, 6, 7); }
    f32x16 O[4];
#pragma unroll
    for (int d = 0; d < 4; ++d)
#pragma unroll
        for (int r = 0; r < 16; ++r) O[d][r] = 0.f;
    float lrun = 0.f;
    const int NT = 4 * (qb + 1);
    unsigned kgo[2], klo[2], vgo[2], vlo[2];
#pragma unroll
    for (int i = 0; i < 2; ++i) { const int id = tid + 512 * i, key = id / 12, ch = id % 12; kgo[i] = (unsigned)(key * NQ + ch * 16); klo[i] = (unsigned)(key * PK8_PITCH + ch * 16); }
#pragma unroll
    for (int i = 0; i < 2; ++i) { const int id = tid + 512 * i, key = id >> 4, ch = id & 15; vgo[i] = (unsigned)(key * DM * 2 + ch * 16); vlo[i] = (unsigned)(2 * PK8B + key * PV_PITCH + ch * 16); }
    const bool k2 = tid < 256;
    const __amdgpu_buffer_rsrc_t Krs = __builtin_amdgcn_make_buffer_rsrc((void*)(K8 + row0 * NQ + h * DQ), 0, SEQ * NQ, 0x00020000);
    const __amdgpu_buffer_rsrc_t Vrs = __builtin_amdgcn_make_buffer_rsrc((void*)(VB + row0 * DM + h * DVH), 0, SEQ * DM * 2, 0x00020000);
    v4u kr[2], vr[2];
#define PA_LOAD(t) do { const int kso_ = (t) * (64 * NQ), vso_ = (t) * (64 * DM * 2); \
                        kr[0] = __builtin_amdgcn_raw_buffer_load_b128(Krs, kgo[0], kso_, 0); if (k2) kr[1] = __builtin_amdgcn_raw_buffer_load_b128(Krs, kgo[1], kso_, 0); \
                        _Pragma("unroll") for (int i = 0; i < 2; ++i) vr[i] = __builtin_amdgcn_raw_buffer_load_b128(Vrs, vgo[i], vso_, 0); } while (0)
#define PA_STORE(bufi) do { *(LAS v4u*)(lds + (bufi) * PK8B + klo[0]) = kr[0]; if (k2) *(LAS v4u*)(lds + (bufi) * PK8B + klo[1]) = kr[1]; \
                            _Pragma("unroll") for (int i = 0; i < 2; ++i) *(LAS v4u*)(lds + (bufi) * PVB + vlo[i]) = vr[i]; } while (0)
    __syncthreads();
    PA_LOAD(0); PA_STORE(0);
    __syncthreads();
    const int trq = (lane & 15) >> 2, trp = lane & 3, trblk = (lane >> 4) & 1;
    for (int t = 0; t < NT; ++t) {
        const int bi = t & 1;
        if (t + 1 < NT) PA_LOAD(t + 1);
        const LAS unsigned char* Kb = lds + bi * PK8B; const LAS unsigned char* Vb = lds + 2 * PK8B + bi * PVB;
#pragma unroll
        for (int kb = 0; kb < 2; ++kb) {
            f32x16 S;
#pragma unroll
            for (int r = 0; r < 16; ++r) S[r] = 0.f;
            const LAS unsigned char* kp = Kb + (32 * kb + n) * PK8_PITCH + 32 * hi;
            const LAS unsigned char* vp = Vb + (32 * kb + 4 * hi + trq) * PV_PITCH + (16 * trblk) * 2 + 8 * trp;
            v4u ka[3][2]; s16x4 vl[2][4], vh[2][4];
#pragma unroll
            for (int s = 0; s < 3; ++s) { ka[s][0] = *(const LAS v4u*)(kp + 64 * s); ka[s][1] = *(const LAS v4u*)(kp + 64 * s + 16); }
#pragma unroll
            for (int s2 = 0; s2 < 2; ++s2)
#pragma unroll
                for (int d = 0; d < 4; ++d) { vl[s2][d] = trread(vp + (16 * s2) * PV_PITCH + 64 * d); vh[s2][d] = trread(vp + (16 * s2 + 8) * PV_PITCH + 64 * d); }
            __builtin_amdgcn_sched_barrier(0);
#pragma unroll
            for (int s = 0; s < 3; ++s) S = MFMA8(__builtin_shufflevector(__builtin_bit_cast(v4i_t, ka[s][0]), __builtin_bit_cast(v4i_t, ka[s][1]), 0, 1, 2, 3, 4, 5, 6, 7), qf[s], S);
            __builtin_amdgcn_sched_barrier(0);
            if (t >= NT - 4) {
#pragma unroll
                for (int r = 0; r < 16; ++r) { const int key = 64 * t + 32 * kb + crow(r, hi); if (key > qrow) S[r] = -1e30f; }
            }
            float ls = 0.f;
#pragma unroll
            for (int r = 0; r < 16; ++r) { const float p = fexp2(S[r] * (1.0f / 64.0f) - SM_SHIFT); S[r] = p; ls += p; }
            lrun += ls;
            const bf16x8 p0 = pack8<0>(S), p1 = pack8<1>(S);
#pragma unroll
            for (int s2 = 0; s2 < 2; ++s2) {
                const bf16x8 pf = s2 == 0 ? p0 : p1;
#pragma unroll
                for (int d = 0; d < 4; ++d) O[d] = MFMA32(cat8(vl[s2][d], vh[s2][d]), pf, O[d]);
            }
        }
        if (t + 1 < NT) PA_STORE(bi ^ 1);
        __syncthreads();
    }
#undef PA_LOAD
#undef PA_STORE
    const float linv = 1.0f / (lrun + __shfl_xor(lrun, 32));
    bf16* op = ATT + (row0 + qrow) * DM + h * DVH + 4 * hi;
#pragma unroll
    for (int d = 0; d < 4; ++d)
#pragma unroll
        for (int g = 0; g < 4; ++g) { u32x2 w; w.x = pk2(O[d][4 * g] * linv, O[d][4 * g + 1] * linv); w.y = pk2(O[d][4 * g + 2] * linv, O[d][4 * g + 3] * linv); *(u32x2*)(op + 32 * d + 8 * g) = w; }
}

constexpr int C8_STRIDE = 2080;

constexpr int OI_PITCH = 528;
DI void sample_merge_unit(const Ctx& C, int seq, int rb) {
    const Args& A = *C.a; unsigned char* ws = A.ws; LAS unsigned char* lds = C.lds;
    int tid_ = threadIdx.x; asm volatile("" : "+v"(tid_)); const int tid = tid_, lane = tid & 63, wid = C.wave, n = lane & 31, hi = lane >> 5;
    __syncthreads();
    {
        const int rn = tid & 31, dg = tid >> 5;
        const float* PML = (const float*)(ws + WS_PML); const float* PO = (const float*)(ws + WS_PO);
        const size_t u0 = ((size_t)(seq * 2 + 0) * 2 + rb), u1 = ((size_t)(seq * 2 + 1) * 2 + rb);
        const float m0 = PML[(u0 * 32 + rn) * 2], l0 = PML[(u0 * 32 + rn) * 2 + 1], m1 = PML[(u1 * 32 + rn) * 2], l1 = PML[(u1 * 32 + rn) * 2 + 1];
        const float mt = fmaxf(m0, m1), w0 = fexp2(m0 - mt), w1 = fexp2(m1 - mt), Li = 1.0f / (w0 * l0 + w1 * l1);
#pragma unroll 4
        for (int j = 0; j < 16; ++j) {
            const int dv = dg * 16 + j;
            const float o = w0 * PO[(u0 * 256 + dv) * 32 + rn] + w1 * PO[(u1 * 256 + dv) * 32 + rn];
            *(LAS bf16*)(lds + rn * OI_PITCH + dv * 2) = (bf16)f2bf(o * Li);
        }
    }
    __syncthreads();
    {
        const int hl = wid >> 1, h = 4 * rb + hl, d0 = 2 * (wid & 1);
        const bf16* WUV = (const bf16*)(ws + WS_WUKV) + (size_t)(1024 + h * DVH) * RL; bf16* ATT = (bf16*)(ws + WS_ATT);
        f32x16 acc[2];
#pragma unroll
        for (int d = 0; d < 2; ++d)
#pragma unroll
            for (int r = 0; r < 16; ++r) acc[d][r] = 0.f;
#pragma unroll 4
        for (int s = 0; s < 16; ++s) {
            bf16x8 bfr = *(const LAS bf16x8*)(lds + (hl * 8 + (n & 7)) * OI_PITCH + (16 * s + 8 * hi) * 2);
            if (n >= DEC_T) bfr = (bf16x8){0, 0, 0, 0, 0, 0, 0, 0};
#pragma unroll
            for (int d = 0; d < 2; ++d) acc[d] = MFMA32(*(const bf16x8*)(WUV + (size_t)(32 * (d0 + d) + n) * RL + 16 * s + 8 * hi), bfr, acc[d]);
        }
        if (n < DEC_T) {
            bf16* op = ATT + (size_t)(NP + seq * DEC_T + n) * DM + h * DVH + 4 * hi;
#pragma unroll
            for (int d = 0; d < 2; ++d)
#pragma unroll
                for (int g = 0; g < 4; ++g) { u32x2 w; w.x = pk2(acc[d][4 * g], acc[d][4 * g + 1]); w.y = pk2(acc[d][4 * g + 2], acc[d][4 * g + 3]); *(u32x2*)(op + 32 * (d0 + d) + 8 * g) = w; }
        }
    }
}

constexpr int GV_PITCH = 544;
DI void gmlp_stage(const Ctx& C, int chunk, int g, int boff) {
    unsigned char* ws = C.a->ws; LAS unsigned char* lds = C.lds + boff;
    int tid_ = threadIdx.x; asm volatile("" : "+v"(tid_)); const int tid = tid_;
    const bf16* VN = (const bf16*)(ws + WS_VG); const size_t r0 = (size_t)chunk * 128;
#pragma unroll
    for (int i = 0; i < 8; ++i) { const int id = tid + 512 * i, s = id >> 5, ch = id & 31; *(LAS v4u*)(lds + s * GV_PITCH + ch * 16) = *(const v4u*)(VN + (r0 + s) * DM + g * 256 + ch * 8); }
}
DI void gmlp_compute(const Ctx& C, int chunk, int g, int boff) {
    const Args& A = *C.a; unsigned char* ws = A.ws; LAS unsigned char* lds = C.lds + boff;
    int tid_ = threadIdx.x; asm volatile("" : "+v"(tid_)); const int tid = tid_, lane = tid & 63, wid = C.wave, n = lane & 31, hi = lane >> 5;
    const bf16* U = (const bf16*)(ws + WS_U); const bf16* WST = (const bf16*)(ws + WS_WST) + (size_t)g * 128 * 128; bf16* GM = (bf16*)(ws + WS_GM);
    const float* bs = (const float*)A.in[22] + g * 128;
    const size_t r0 = (size_t)chunk * 128;
    f32x16 acc[4];
#pragma unroll
    for (int tb = 0; tb < 4; ++tb)
#pragma unroll
        for (int r = 0; r < 16; ++r) acc[tb][r] = 0.f;
    const int trq = (lane & 15) >> 2, trp = lane & 3, trblk = (lane >> 4) & 1;
#pragma unroll
    for (int ks = 0; ks < 8; ++ks) {
        const LAS unsigned char* vp = lds + (16 * ks + 8 * hi + trq) * GV_PITCH + (32 * wid + 16 * trblk) * 2 + 8 * trp;
        const bf16x8 af = cat8(trread(vp), trread(vp + 4 * GV_PITCH));
#pragma unroll
        for (int tb = 0; tb < 4; ++tb) {
            if (2 * tb + 1 >= ks) { const bf16x8 bfr = *(const bf16x8*)(WST + (size_t)(32 * tb + n) * 128 + 16 * ks + 8 * hi); acc[tb] = MFMA32(af, bfr, acc[tb]); }
        }
    }
#pragma unroll
    for (int tb = 0; tb < 4; ++tb) {
        const int t = 32 * tb + n; const float bias = bs[t];
        const size_t off = (r0 + t) * DM + g * 256 + 32 * wid + 4 * hi;
#pragma unroll
        for (int q = 0; q < 4; ++q) {
            const u32x2 uu = *(const u32x2*)(U + off + 8 * q);
            u32x2 w; w.x = pk2(bflo(uu.x) * (acc[tb][4 * q] + bias), bfhi(uu.x) * (acc[tb][4 * q + 1] + bias)); w.y = pk2(bflo(uu.y) * (acc[tb][4 * q + 2] + bias), bfhi(uu.y) * (acc[tb][4 * q + 3] + bias));
            *(u32x2*)(GM + off + 8 * q) = w;
        }
    }
}
DI void gmlp_sample_unit(const Ctx& C, int seq) {
    const Args& A = *C.a; unsigned char* ws = A.ws; int tid_ = threadIdx.x; asm volatile("" : "+v"(tid_)); const int lane = tid_ & 63, t = C.wave;
    const bf16* VN = (const bf16*)(ws + WS_VG); const bf16* U = (const bf16*)(ws + WS_U); bf16* GM = (bf16*)(ws + WS_GM);
    const float* wsrc = (const float*)A.in[21]; const float* bsrc = (const float*)A.in[22];
    const size_t r0 = (size_t)NP + (size_t)seq * DEC_T;
#pragma unroll
    for (int g = 0; g < 4; ++g) {
        float a0 = 0.f, a1 = 0.f, a2 = 0.f, a3 = 0.f;
        for (int s = 0; s <= t; ++s) {
            const float w = wsrc[(g * 128 + t) * 128 + s];
            const u32x2 vv = *(const u32x2*)(VN + (r0 + s) * DM + g * 256 + 4 * lane);
            a0 += w * bflo(vv.x); a1 += w * bfhi(vv.x); a2 += w * bflo(vv.y); a3 += w * bfhi(vv.y);
        }
        const float bias = bsrc[g * 128 + t];
        const size_t off = (r0 + t) * DM + g * 256 + 4 * lane;
        const u32x2 uu = *(const u32x2*)(U + off);
        u32x2 w; w.x = pk2(bflo(uu.x) * (a0 + bias), bfhi(uu.x) * (a1 + bias)); w.y = pk2(bflo(uu.y) * (a2 + bias), bfhi(uu.y) * (a3 + bias));
        *(u32x2*)(GM + off) = w;
    }
}

constexpr int FS_C8 = 0, FS_CTP = 544, FS_CT = 20 * C8_STRIDE, FS_Q8 = FS_CT + 128 * FS_CTP, FS_P = FS_Q8 + 10 * C8_STRIDE, FS_RT = FS_P + 16384, FS_END = FS_RT + 4096;
static_assert(FS_END <= MISC_OFF && (FS_CT % 16) == 0 && (FS_Q8 % 16) == 0 && (FS_P % 16) == 0, "fused sample attention LDS map");
DI u32x2 bf8_to_fp8(const v4u w) { return (u32x2){fp8x4(bflo(w.x), bfhi(w.x), bflo(w.y), bfhi(w.y)), fp8x4(bflo(w.z), bfhi(w.z), bflo(w.w), bfhi(w.w))}; }
constexpr int F2_CBUF = 20 * C8_STRIDE, F2_Q8 = 2 * F2_CBUF, F2_P = F2_Q8 + 10 * C8_STRIDE, F2_RT = F2_P + 16384, F2_END = F2_RT + 4096;
static_assert(F2_END <= MISC_OFF && (F2_Q8 % 16) == 0 && (F2_P % 16) == 0, "fused sample attention v2 LDS map");
constexpr float C6_SC = 0.5f;
#define F6_FRAG(pa_, pb_) __builtin_shufflevector(__builtin_bit_cast(v4i_t, *(const LAS v4u*)(pa_)), __builtin_shufflevector(__builtin_bit_cast(v2i_t, *(const LAS u32x2*)(pb_)), __builtin_bit_cast(v2i_t, *(const LAS u32x2*)(pb_)), 0, 1, -1, -1), 0, 1, 2, 3, 4, 5, 6, 7)
#define CVTF8(a, b) (u32x2){fp8x4((a)[0], (a)[1], (a)[2], (a)[3]), fp8x4((b)[0], (b)[1], (b)[2], (b)[3])}
DI void fused_sample_unit2(const Ctx& C, int seq, int half, const int pflags = 0) {
#define FSU2_SIG
    const Args& A = *C.a; unsigned char* ws = A.ws; LAS unsigned char* lds = C.lds;
    const int wid = C.wave;
#define LANE_NOW() ((int)__builtin_amdgcn_mbcnt_hi(~0u, __builtin_amdgcn_mbcnt_lo(~0u, 0u)))
#define OPQ_TID(t) int t = wid * 64 + LANE_NOW(); asm volatile("" : "+v"(t))
#define OPQ_LANE(l_, n_, h_) int l_ = LANE_NOW(); asm volatile("" : "+v"(l_)); const int n_ = l_ & 31, h_ = l_ >> 5
    const int* pt = (const int*)A.in[4] + seq * NPAGES;
    int ptv; { const int l_ = LANE_NOW() & 31; ptv = pt[half * 32 + l_]; }
    const bf16* QN = (const bf16*)(ws + WS_QN); const bf16* WUKO = (const bf16*)(ws + WS_WUKO);
    const __amdgpu_buffer_rsrc_t Lrs = __builtin_amdgcn_make_buffer_rsrc((void*)A.in[2], 0, 0x50000000u, 0x00020000);
    const __amdgpu_buffer_rsrc_t Rrs = __builtin_amdgcn_make_buffer_rsrc((void*)A.in[3], 0, 0x14000000u, 0x00020000);
    const __amdgpu_buffer_rsrc_t Wrs = __builtin_amdgcn_make_buffer_rsrc((void*)(ws + WS_WF + (size_t)wid * 24576), 0, 24576, 0x00020000);
    const __amdgpu_buffer_rsrc_t NRrs = __builtin_amdgcn_make_buffer_rsrc((void*)((const float*)(ws + WS_RS) + ((size_t)seq * SKEYS + PAST) * NH), 0, DEC_T * NH * 4, 0x00020000);
    const __amdgpu_buffer_rsrc_t NLrs = __builtin_amdgcn_make_buffer_rsrc((void*)((const bf16*)(ws + WS_LATB) + (size_t)(NP + seq * DEC_T) * RL), 0, DEC_T * RL * 2, 0x00020000);
    const __amdgpu_buffer_rsrc_t NKrs = __builtin_amdgcn_make_buffer_rsrc((void*)((const bf16*)(ws + WS_KRB) + (size_t)(NP + seq * DEC_T) * DR), 0, DEC_T * DR * 2, 0x00020000);
#define LBAR2() do { asm volatile("s_waitcnt lgkmcnt(0)" ::: "memory"); __builtin_amdgcn_s_barrier(); asm volatile("" ::: "memory"); } while (0)
#define LDF4(rs, vo, so) __builtin_bit_cast(f32x4, __builtin_amdgcn_raw_buffer_load_b128(rs, vo, so, 0))
#define CVT8(a, b) (v4u){pk2((a)[0], (a)[1]), pk2((a)[2], (a)[3]), pk2((b)[0], (b)[1]), pk2((b)[2], (b)[3])}
    __syncthreads();
    {
        const int h = wid; OPQ_LANE(lane, n, hi);
        bf16x8 bq[8];
        const __amdgpu_buffer_rsrc_t Qrs = __builtin_amdgcn_make_buffer_rsrc((void*)(QN + (size_t)(NP + seq * DEC_T) * NQ), 0, DEC_T * NQ * 2, 0x00020000);
        const __amdgpu_buffer_rsrc_t WOrs = __builtin_amdgcn_make_buffer_rsrc((void*)WUKO, 0, RL * 1024 * 2, 0x00020000);
        const unsigned qvo = (unsigned)(((n & 7) * NQ + h * DQ + 8 * hi) * 2), wvo0 = (unsigned)(h * 65536 + lane * 16);
#pragma unroll
        for (int s = 0; s < 8; ++s) { bq[s] = __builtin_bit_cast(bf16x8, __builtin_amdgcn_raw_buffer_load_b128(Qrs, qvo, 32 * s, 0)); if (n >= DEC_T) bq[s] = (bf16x8){0, 0, 0, 0, 0, 0, 0, 0}; }
#pragma unroll 2
        for (int jb = 0; jb < 8; ++jb) {
            f32x16 acc;
#pragma unroll
            for (int r = 0; r < 16; ++r) acc[r] = 0.f;
#pragma unroll
            for (int s = 0; s < 8; ++s) acc = MFMA32(__builtin_bit_cast(bf16x8, __builtin_amdgcn_raw_buffer_load_b128(WOrs, wvo0, (jb * 8 + s) * 1024, 0)), bq[s], acc);
            if (n < DEC_T) {
                const int row = h * 8 + n, rbq = row >> 5;
#pragma unroll
                for (int r = 0; r < 16; ++r) {
                    const int jl = 32 * jb + crow(r, hi), j = 32 * ((jl >> 3) & 7) + 8 * (jl >> 6) + 2 * (jl & 3) + ((jl >> 2) & 1);
                    const unsigned b8 = fp8x4(64.f * acc[r], 0.f, 0.f, 0.f) & 0xffu;
                    *(LAS unsigned char*)(lds + F2_Q8 + (rbq * 5 + (j >> 6)) * C8_STRIDE + ((j >> 5) & 1) * 1040 + ((row & 31) + 32 * ((j >> 4) & 1)) * 16 + (j & 15)) = (unsigned char)b8;
                }
            }
        }
        {
            OPQ_TID(tq_); const int row = tq_ >> 3, c8 = tq_ & 7, hh = row >> 3, q = row & 7;
            const v4u v = __builtin_amdgcn_raw_buffer_load_b128(Qrs, (unsigned)((q * NQ + hh * DQ + DN + c8 * 8) * 2), 0, 0);
            const u32x2 f = (u32x2){fp8x4(64.f * bflo(v.x), 64.f * bfhi(v.x), 64.f * bflo(v.y), 64.f * bfhi(v.y)), fp8x4(64.f * bflo(v.z), 64.f * bfhi(v.z), 64.f * bflo(v.w), 64.f * bfhi(v.w))};
            *(LAS u32x2*)(lds + F2_Q8 + ((row >> 5) * 5 + 4) * C8_STRIDE + ((c8 >> 1) & 1) * 1040 + ((row & 31) + 32 * ((c8 >> 2) & 1)) * 16 + (c8 & 1) * 8) = f;
        }
    }
    const int rb = wid >> 2, jq = wid & 3;
    v4u wfa[4]; u32x2 wfb[4];
    { const unsigned wvo = (unsigned)LANE_NOW() * 16u;
#pragma unroll
    for (int i = 0; i < 4; ++i) { wfa[i] = __builtin_amdgcn_raw_buffer_load_b128(Wrs, wvo, i * 1536, 0); wfb[i] = __builtin_bit_cast(u32x2, __builtin_amdgcn_raw_buffer_load_b64(Wrs, wvo >> 1, i * 1536 + 1024, 0)); } }
#define LGO_(t) ((unsigned)(((t) >> 3) * RL * 4 + ((t) & 7) * 32))
#define RGO_(t) ((unsigned)(((t) >> 3) * DR * 4 + ((t) & 7) * 32))
#define CT_ITEM(t) ((unsigned)(FS_CT + ((t) >> 5) * FS_CTP + ((t) & 31) * 16))
#define C6_FRAG(t) ((unsigned)(((((t) >> 8) & 1) * 5 + (((t) & 7) >> 1)) * C8_STRIDE))
#define C6_LANE(t) ((((t) >> 3) & 31) + 32 * ((t) & 1))
#define R8_ITEM(t) ((unsigned)(FS_C8 + ((((t) >> 3) >> 5) * 5 + 4) * C8_STRIDE + ((((t) & 7) >> 1) & 1) * 1040 + ((((t) >> 3) & 31) + 32 * ((((t) & 7) >> 2) & 1)) * 16 + ((t) & 1) * 8))
    f32x16 O[2];
#pragma unroll
    for (int d = 0; d < 2; ++d)
#pragma unroll
        for (int r = 0; r < 16; ++r) O[d][r] = 0.f;
    float lrun = 0.f;
    const int p0 = half * 32, np = 32 + half;
#define F_WRUNIT(u_, base_) do { OPQ_TID(t6_); const v6u_t v6_ = f6x32(RA[0], RA[1], RA[2], RA[3], RB[0], RB[1], RB[2], RB[3], C6_SC); LAS unsigned char* fb_ = lds + (base_) + C6_FRAG(t6_) + (u_) * (10 * C8_STRIDE); *(LAS v4u*)(fb_ + C6_LANE(t6_) * 16) = (v4u){v6_[0], v6_[1], v6_[2], v6_[3]}; *(LAS u32x2*)(fb_ + 1040 + C6_LANE(t6_) * 8) = (u32x2){v6_[4], v6_[5]}; } while (0)
#define F_LDUNIT(so) do { OPQ_TID(t2_); const unsigned lgo = LGO_(t2_); _Pragma("unroll") for (int k = 0; k < 4; ++k) { RA[k] = LDF4(Lrs, lgo + 256 * k, (so)); RB[k] = LDF4(Lrs, lgo + 256 * k + 16, (so)); } } while (0)
    {
        f32x4 RA[4], RB[4];
        const unsigned sp = (unsigned)__builtin_amdgcn_readlane(ptv, 0); const unsigned sl = sp * (unsigned)(PAGE * RL * 4), sr = sp * (unsigned)(PAGE * DR * 4);
        F_LDUNIT(sl); F_WRUNIT(0, 0);
        F_LDUNIT(sl + 65536); F_WRUNIT(1, 0);
        OPQ_TID(t0_); const unsigned rgo = RGO_(t0_); const unsigned r8_item = R8_ITEM(t0_);
#pragma unroll
        for (int k = 0; k < 2; ++k) { const f32x4 a = LDF4(Rrs, rgo, sr + k * 16384), b = LDF4(Rrs, rgo + 16, sr + k * 16384); *(LAS u32x2*)(lds + r8_item + k * (10 * C8_STRIDE)) = CVTF8(a, b); }
    }
    int cur = 0;
    for (int ip = 0; ip < np; ++ip) {
        const bool newtile = ip == 32;
        LBAR2();
        const int cb0 = cur * F2_CBUF, nb0 = (cur ^ 1) * F2_CBUF;
        OPQ_TID(tn_);
        if (newtile && tn_ < 256) {
            const int key = tn_ >> 1, h4 = (tn_ & 1) * 4;
            f32x4 rv = {0.f, 0.f, 0.f, 0.f};
            rv = __builtin_bit_cast(f32x4, __builtin_amdgcn_raw_buffer_load_b128(NRrs, (unsigned)((key * NH + h4) * 4), 0, 0));
            *(LAS f32x4*)(lds + F2_RT + (key * 8 + h4) * 4) = rv;
        }
        const int ipn = ip + 1; const bool hn = ipn < np, nnew = ipn == 32;
        const unsigned spn = (unsigned)__builtin_amdgcn_readlane(ptv, (hn && !nnew && !(pflags & 1)) ? ipn : 0);
        const unsigned sl = spn * (unsigned)(PAGE * RL * 4), sr = spn * (unsigned)(PAGE * DR * 4);
        f32x4 RA[4], RB[4], RR[4];
        if (!newtile && !(pflags & 2)) {
            float ssq[4] = {0.f, 0.f, 0.f, 0.f};
            int ln1 = LANE_NOW(); asm volatile("" : "+v"(ln1)); const LAS unsigned char* cbuf = lds + cb0 + ln1 * 16; const LAS unsigned char* cbufb = lds + cb0 + 1040 + ln1 * 8; const unsigned wvo = (unsigned)ln1 * 16u, wvob = (unsigned)ln1 * 8u;
#define F_RD1(da_, db2_, s_, kb_) do { da_ = *(const LAS v4u*)(cbuf + ((kb_) * 5 + (s_)) * C8_STRIDE); db2_ = *(const LAS u32x2*)(cbufb + ((kb_) * 5 + (s_)) * C8_STRIDE); } while (0)
#define F6_OP(a_, b_) __builtin_shufflevector(__builtin_bit_cast(v4i_t, a_), __builtin_shufflevector(__builtin_bit_cast(v2i_t, b_), __builtin_bit_cast(v2i_t, b_), 0, 1, -1, -1), 0, 1, 2, 3, 4, 5, 6, 7)
#define F_MM1(sa_, sb_, s_, kb_) do { __builtin_amdgcn_s_setprio(1); acc[kb_] = __builtin_amdgcn_mfma_scale_f32_32x32x64_f8f6f4(F6_OP(wfa[s_], wfb[s_]), F6_OP(sa_, sb_), acc[kb_], 2, 2, 0, 0, 0, 0); __builtin_amdgcn_s_setprio(0); } while (0)
#define F_WRL(s_) do { wfa[s_] = __builtin_amdgcn_raw_buffer_load_b128(Wrs, wvo, wnext + (s_) * 1536, 0); wfb[s_] = __builtin_bit_cast(u32x2, __builtin_amdgcn_raw_buffer_load_b64(Wrs, wvob, wnext + (s_) * 1536 + 1024, 0)); } while (0)
#define F_DBBODY(db_, PRE, POST) do { \
            const int wnext = (((db_) + 1) & 3) * 6144; \
            f32x16 acc[4]; \
            _Pragma("unroll") for (int kb = 0; kb < 4; ++kb) _Pragma("unroll") for (int r = 0; r < 16; ++r) acc[kb][r] = 0.f; \
            v4u caa[3]; u32x2 cab[3]; \
            _Pragma("unroll") for (int s = 0; s < 4; ++s) { \
                F_RD1(caa[0], cab[0], s, 0); F_RD1(caa[1], cab[1], s, 1); F_RD1(caa[2], cab[2], s, 2); \
                if (s == 0) { PRE; } \
                if (s == 1) { POST; } \
                F_MM1(caa[0], cab[0], s, 0); __builtin_amdgcn_sched_barrier(0); F_RD1(caa[0], cab[0], s, 3); F_MM1(caa[1], cab[1], s, 1); F_MM1(caa[2], cab[2], s, 2); F_MM1(caa[0], cab[0], s, 3); F_WRL(s); \
                __builtin_amdgcn_sched_barrier(0); \
            } \
            _Pragma("unroll") for (int kb = 0; kb < 4; ++kb) _Pragma("unroll") for (int r = 0; r < 16; ++r) ssq[kb] += acc[kb][r] * acc[kb][r]; \
            __builtin_amdgcn_sched_barrier(0); } while (0)
            const bool pf = hn && !nnew;
#pragma nounroll
            for (int d2 = 0; d2 < 2; ++d2) {
                F_DBBODY(2 * d2, (void)0, if (pf && d2 == (wid >> 2)) { F_LDUNIT(sl); });
                F_DBBODY(2 * d2 + 1, (void)0, (void)0);
            }
#undef F_RD1
#undef F_MM1
#undef F6_OP
#undef F_WRL
#undef F_DBBODY
#pragma unroll
            for (int kb = 0; kb < 4; ++kb) {
                const float tt = ssq[kb] + __shfl_xor(ssq[kb], 32);
                if ((ln1 >> 5) == 0) *(LAS float*)(lds + F2_RT + ((32 * kb + (ln1 & 31)) * 8 + wid) * 4) = rsqrtf(tt * (1.0f / (128.0f * 4096.0f)) + EPS);
            }
        }
        if (hn && !nnew) {
            F_WRUNIT(0, nb0); F_LDUNIT(sl + 65536);
            OPQ_TID(t3_); const unsigned rgo = RGO_(t3_);
            RR[0] = LDF4(Rrs, rgo, sr); RR[1] = LDF4(Rrs, rgo + 16, sr); RR[2] = LDF4(Rrs, rgo, sr + 16384); RR[3] = LDF4(Rrs, rgo + 16, sr + 16384);
        }
        LBAR2();
        f32x16 Sn, Sr;
#pragma unroll
        for (int r = 0; r < 16; ++r) { Sn[r] = 0.f; Sr[r] = 0.f; }
        int ln2 = LANE_NOW(); asm volatile("" : "+v"(ln2)); const int n2 = ln2 & 31, hi2 = ln2 >> 5, myh = 4 * rb + (n2 >> 3), myq = n2 & 7;
        {
            const LAS unsigned char* kf = lds + cb0 + (jq * 5) * C8_STRIDE + ln2 * 16; const LAS unsigned char* kfb = lds + cb0 + (jq * 5) * C8_STRIDE + 1040 + ln2 * 8; const LAS unsigned char* qf = lds + F2_Q8 + (rb * 5) * C8_STRIDE + ln2 * 16;
#pragma unroll
            for (int s = 0; s < 5; ++s) {
                const v8i_t ka = s < 4 ? F6_FRAG(kf + s * C8_STRIDE, kfb + s * C8_STRIDE) : __builtin_shufflevector(__builtin_bit_cast(v4i_t, *(const LAS v4u*)(kf + s * C8_STRIDE)), __builtin_bit_cast(v4i_t, *(const LAS v4u*)(kf + s * C8_STRIDE + 1040)), 0, 1, 2, 3, 4, 5, 6, 7);
                const v8i_t qa = __builtin_shufflevector(__builtin_bit_cast(v4i_t, *(const LAS v4u*)(qf + s * C8_STRIDE)), __builtin_bit_cast(v4i_t, *(const LAS v4u*)(qf + s * C8_STRIDE + 1040)), 0, 1, 2, 3, 4, 5, 6, 7);
                if (s < 4) Sn = __builtin_amdgcn_mfma_scale_f32_32x32x64_f8f6f4(ka, qa, Sn, 2, 0, 0, 0, 0, 0);
                else       Sr = __builtin_amdgcn_mfma_scale_f32_32x32x64_f8f6f4(ka, qa, Sr, 0, 0, 0, 0, 0, 0);
                __builtin_amdgcn_sched_barrier(0);
            }
        }
        float ls = 0.f;
#pragma unroll
        for (int r = 0; r < 16; ++r) {
            const int kl = 32 * jq + crow(r, hi2);
            const float s = (Sn[r] * (0.5f * *(const LAS float*)(lds + F2_RT + (kl * 8 + myh) * 4)) + Sr[r]) * (1.0f / 64.0f);
            const float p = (newtile && kl > myq) ? 0.f : fexp2(s - SM_SHIFT);
            Sn[r] = p; ls += p;
        }
        lrun += ls;
        *(LAS bf16x8*)(lds + F2_P + ((rb * 4 + jq) * 2 + 0) * 1024 + ln2 * 16) = pack8<0>(Sn);
        *(LAS bf16x8*)(lds + F2_P + ((rb * 4 + jq) * 2 + 1) * 1024 + ln2 * 16) = pack8<1>(Sn);
        LBAR2();
        {
            int ln3 = LANE_NOW(); asm volatile("" : "+v"(ln3)); const int n3 = ln3 & 31, kh3 = ln3 >> 5;
            const LAS unsigned char* pbase = lds + F2_P + rb * 8192 + ln3 * 16;
            const LAS unsigned char* cfb = lds + cb0 + jq * C8_STRIDE + ln3 * 16; const LAS unsigned char* cfbb = lds + cb0 + jq * C8_STRIDE + 1040 + ln3 * 8;
            v8i_t idm[2];
#pragma unroll
            for (int d = 0; d < 2; ++d)
#pragma unroll
                for (int w = 0; w < 8; ++w) idm[d][w] = (kh3 == d && ((6 * n3 + 3) >> 5) == w) ? (int)(1u << ((6 * n3 + 3) & 31)) : 0;
#pragma unroll
            for (int kq = 0; kq < 4; ++kq) {
                const v8i_t cf = F6_FRAG(cfb + kq * (5 * C8_STRIDE), cfbb + kq * (5 * C8_STRIDE));
                const bf16x8 pf0 = *(const LAS bf16x8*)(pbase + (2 * kq) * 1024), pf1 = *(const LAS bf16x8*)(pbase + (2 * kq + 1) * 1024);
#pragma unroll
                for (int d = 0; d < 2; ++d) {
                    f32x16 T;
#pragma unroll
                    for (int r = 0; r < 16; ++r) T[r] = 0.f;
                    T = __builtin_amdgcn_mfma_scale_f32_32x32x64_f8f6f4(cf, idm[d], T, 2, 2, 0, 0, 0, 0);
                    O[d] = MFMA32(pack8<0>(T), pf0, O[d]);
                    O[d] = MFMA32(pack8<1>(T), pf1, O[d]);
                }
            }
        }
        if (hn && !nnew) {
            F_WRUNIT(1, nb0);
            OPQ_TID(t7_); LAS unsigned char* rd_ = lds + nb0 + R8_ITEM(t7_);
            *(LAS u32x2*)rd_ = CVTF8(RR[0], RR[1]); *(LAS u32x2*)(rd_ + 10 * C8_STRIDE) = CVTF8(RR[2], RR[3]);
        } else if (nnew) {
            OPQ_TID(t4_);
            {
#pragma unroll
                for (int k = 0; k < 4; ++k) { const v4u l = __builtin_amdgcn_raw_buffer_load_b128(NLrs, (unsigned)((t4_ >> 3) * RL * 2 + 128 * k + (t4_ & 7) * 16), 0, 0);
                    RA[k] = (f32x4){bflo(l.x), bfhi(l.x), bflo(l.y), bfhi(l.y)}; RB[k] = (f32x4){bflo(l.z), bfhi(l.z), bflo(l.w), bfhi(l.w)}; }
                F_WRUNIT(0, nb0); }
            const v4u kv = __builtin_amdgcn_raw_buffer_load_b128(NKrs, (unsigned)((t4_ >> 3) * DR * 2 + (t4_ & 7) * 16), 0, 0);
            *(LAS u32x2*)(lds + nb0 + R8_ITEM(t4_)) = bf8_to_fp8(kv);
        }
        cur ^= 1;
    }
#undef F_LDUNIT
#undef F_WRUNIT
    float ltot = lrun + __shfl_xor(lrun, 32);
    OPQ_LANE(lane, n, hi);
    LBAR2();
    if (hi == 0) *(LAS float*)(lds + F2_RT + ((rb * 4 + jq) * 32 + n) * 4) = ltot;
    LBAR2();
    { const LAS float* st = (const LAS float*)(lds + F2_RT + (rb * 4 * 32 + n) * 4); ltot = (st[0] + st[32]) + (st[64] + st[96]); }
    float* PO = (float*)(ws + WS_PO) + ((size_t)(seq * 2 + half) * 2 + rb) * (256 * 32);
#pragma unroll
    for (int d = 0; d < 2; ++d)
#pragma unroll
        for (int r = 0; r < 16; ++r) { const int pp = 64 * jq + 32 * d + crow(r, hi); PO[(64 * ((pp & 31) >> 3) + 8 * (pp >> 5) + 4 * (pp & 1) + ((pp >> 1) & 3)) * 32 + n] = 0.5f * O[d][r]; }
    if (hi == 0 && jq == 0) { float* pm = (float*)(ws + WS_PML) + (((size_t)(seq * 2 + half) * 2 + rb) * 32 + n) * 2; pm[0] = 0.f; pm[1] = ltot; }
    LBAR2();
#undef LBAR2
#undef LDF4
#undef CVT8
#undef OPQ_LANE
#undef LANE_NOW
#undef OPQ_TID
#undef LGO_
#undef RGO_
#undef CT_ITEM
#undef C6_FRAG
#undef C6_LANE
#undef R8_ITEM
}
#undef CVTF8

#ifndef PH_MASK
#define PH_MASK 0xffff
#endif
#define PH(k) (((PH_MASK) >> (k)) & 1)
__global__ void __launch_bounds__(NWAVES * 64, 2) fused_fwd(Args args) {
    extern __shared__ __attribute__((aligned(16))) unsigned char lds_raw[];
    Ctx C;
    C.lds = (LAS unsigned char*)lds_raw; C.tid = threadIdx.x; C.lane = C.tid & 63; C.wave = __builtin_amdgcn_readfirstlane(C.tid >> 6);
    C.G = gridDim.x; { const int bx = blockIdx.x; C.vcu = (C.G % 8 == 0) ? (bx % 8) * (C.G / 8) + bx / 8 : bx; }
    C.a = &args;
    unsigned char* ws = args.ws;
    volatile LAS unsigned* MISC = (volatile LAS unsigned*)(C.lds + MISC_OFF);
    for (int u = C.tid; u < (LDS_BYTES - MISC_OFF) / 4; u += NWAVES * 64) ((LAS unsigned*)(C.lds + MISC_OFF))[u] = 0u;
    __syncthreads();
    XcdBarrier bar = xcd_barrier_post((unsigned*)(ws + WS_CTL) + CW_BAR, MISC + 8);
#define GRID_BAR() xcd_barrier(bar)
    float* X = args.out + OUT_X;
    bf16* Abuf = (bf16*)(ws + WS_A); bf16* H = (bf16*)(ws + WS_H);
    const int bx = (int)blockIdx.x;

    if (PH(0)) {
    p0_prologue(C);
#ifdef DUP_P0
    p0_prologue(C);
#endif
    }
    GRID_BAR();
    if (PH(1)) {
    {   pg8::Gemm g{Abuf, (const bf16*)(ws + WS_W1GU), MT, NGU, DM}; pg8::StaticOrder S; S.init(MT, NGU, C.G, bx);
        Epi<E_SWIGLU> E{}; E.o0 = H; E.ldc = DFF;
        pg8::gemm_phase<Epi<E_SWIGLU>, pg8::StaticOrder, true, true>(C.lds, g, S, E); }
    }
    GRID_BAR();
    if (PH(2)) {
    {   pg8::Gemm g{H, (const bf16*)(ws + WS_W1D), NP, DM, DFF}; pg8::StaticOrder S; S.init(NP, DM, C.G, bx);
        Epi<E_RESIDN> E{}; E.f0 = X; E.b0 = (const float*)args.in[0]; E.b1 = (const float*)args.in[1]; E.scale = 0.5f;
        E.an = Abuf; E.gn = (const float*)args.in[9]; E.rsp = (float*)(ws + WS_RSP);
        pg8::gemm_phase<Epi<E_RESIDN>, pg8::StaticOrder, true, true>(C.lds, g, S, E);
        gemm_small(C, H, (const bf16*)(ws + WS_W1D), DM, DFF, E); }
    }
    GRID_BAR();
    if (PH(4)) {
    {
        { const float* gq = (const float*)args.in[11]; const float* gkv = (const float*)args.in[13]; const float* gv = (const float*)args.in[20];
          LAS float* G = (LAS float*)(C.lds + XCH_OFF + 4096);
          for (int i = C.tid; i < 1536; i += NWAVES * 64) G[i] = i < 256 ? gq[i] : i < 512 ? gkv[i - 256] : gv[i - 512];
          __syncthreads(); }
        pg8::Gemm g{Abuf, (const bf16*)(ws + WS_WIN), MT, 4608, DM}; pg8::StaticOrder S; S.init(MT, 4608, C.G, bx);
        Epi<E_WIN> E{}; E.wsb = ws; E.outp = args.out; E.xch = C.lds + XCH_OFF; E.ord = 0;
        fill_rowscale(C, S, (const float*)(ws + WS_RSP));
        pg8::gemm_phase<Epi<E_WIN>, pg8::StaticOrder, true, true>(C.lds, g, S, E);
        krope_gemm(C); }
    }
#if defined(DUP_PHASE) && DUP_PHASE == 4
#endif
    GRID_BAR();
    if (PH(6)) {
    int kq_ = RL; asm volatile("" : "+s"(kq_));
    {   const float* gqn = (const float*)args.in[16]; const float* gqr = (const float*)args.in[17]; const float* gkn = (const float*)args.in[18];
        LAS float* G = (LAS float*)(C.lds + XCH_OFF + 8192);
        for (int i = C.tid; i < 320; i += NWAVES * 64) G[i] = i < 128 ? gqn[i] : i < 192 ? gqr[i - 128] : gkn[i - 192];
        __syncthreads(); }
    {
        static_assert(WS_LATB == WS_CQN + (size_t)MT * RL * 2 && WS_WUKV == WS_WUQ + (size_t)NQ * RL * 2, "concatenated operands of the q / latent-expansion stream");
        pg8::Gemm g{(const bf16*)(ws + WS_CQN), (const bf16*)(ws + WS_WUQ), 2 * MT, NQ + 2048, kq_};
        pg8::CatOrder S; S.S1.init(MT, NQ, C.G, bx); S.S2.init(MT, 2048, C.G, bx); S.dpm = MT / 256; S.dpn = NQ / 256;
        Epi<E_QKVN> E{}; E.wsb = ws; E.xch = C.lds + XCH_OFF;
        pg8::gemm_phase<Epi<E_QKVN>, pg8::CatOrder, true, true>(C.lds, g, S, E); }
    }
    GRID_BAR();
    if (PH(8)) {
    {
        const unsigned char* QN = ws + WS_Q8; const unsigned char* K192 = ws + WS_K8; const bf16* VB = (const bf16*)(ws + WS_VB); bf16* ATT = (bf16*)(ws + WS_ATT);
#ifndef P8SEL
#define P8SEL 15
#endif
        if (P8SEL & 1) for (int pu = C.vcu; pu < 256; pu += C.G) {
            const int bh = pu >> 3, s = pu & 7;
            attn_prompt_unit(C, QN, K192, VB, ATT, bh >> 3, bh & 7, 15 - s);
            attn_prompt_unit(C, QN, K192, VB, ATT, bh >> 3, bh & 7, s);
#ifdef DUP_PATTN
            attn_prompt_unit(C, QN, K192, VB, ATT, bh >> 3, bh & 7, 15 - s);
            attn_prompt_unit(C, QN, K192, VB, ATT, bh >> 3, bh & 7, s);
#endif
        }
#ifdef DUP_SATTN
        for (int su = C.vcu; su < 2 * DEC_B; su += C.G) fused_sample_unit2(C, su >> 1, su & 1, DUP_SATTN);
#endif
        if (P8SEL & 2) for (int su = C.vcu; su < 2 * DEC_B; su += C.G) fused_sample_unit2(C, su >> 1, su & 1);
        if (P8SEL & 4) for (int gu = C.vcu; gu < 512; gu += 2 * C.G) {
            const int gu2 = gu + C.G; const bool two = gu2 < 512;
            __syncthreads();
            gmlp_stage(C, gu >> 2, gu & 3, 0); if (two) gmlp_stage(C, gu2 >> 2, gu2 & 3, 128 * GV_PITCH);
            __syncthreads();
            gmlp_compute(C, gu >> 2, gu & 3, 0); if (two) gmlp_compute(C, gu2 >> 2, gu2 & 3, 128 * GV_PITCH);
        }
        if (P8SEL & 8) for (int sq = C.vcu; sq < DEC_B; sq += C.G) gmlp_sample_unit(C, sq);
    }
    }
    GRID_BAR();
    if (PH(9)) {
    for (int mu = C.vcu; mu < 2 * DEC_B; mu += C.G) sample_merge_unit(C, mu >> 1, mu & 1);
    }
    GRID_BAR();
    if (PH(10)) {
    {
        static_assert(WS_GM == WS_ATT + (size_t)MT * DM * 2 && WS_WOG == WS_WOA + (size_t)DM * DM * 2, "concatenated operands of the gated-projection stream");
        pg8::Gemm g{(const bf16*)(ws + WS_ATT), (const bf16*)(ws + WS_WOA), 2 * MT, 2 * DM, DM};
        pg8::CatOrder S; S.S1.init(NP, DM, C.G, bx); S.S2.init(NP, DM, C.G, bx); S.dpm = MT / 256; S.dpn = DM / 256;
        Epi<E_GATEAB> E{}; E.f0 = (float*)(ws + WS_M1); E.g0 = (const bf16*)(ws + WS_GA); E.g1 = (const bf16*)(ws + WS_GG); E.o0 = (bf16*)(ws + WS_MRG);
        pg8::gemm_phase<Epi<E_GATEAB>, pg8::CatOrder, true, true>(C.lds, g, S, E); }
    {   Epi<E_GATEA> E{}; E.f0 = (float*)(ws + WS_M1); E.g0 = (const bf16*)(ws + WS_GA);
        gemm_small(C, (const bf16*)(ws + WS_ATT), (const bf16*)(ws + WS_WOA), DM, DM, E); }
    {   Epi<E_GATEB> E{}; E.o0 = (bf16*)(ws + WS_MRG); E.f0 = (float*)(ws + WS_M1); E.g0 = (const bf16*)(ws + WS_GG);
        gemm_small(C, (const bf16*)(ws + WS_GM), (const bf16*)(ws + WS_WOG), DM, DM, E); }
    }
    GRID_BAR();
    if (PH(11)) {
    {   pg8::Gemm g{(const bf16*)(ws + WS_MRG), (const bf16*)(ws + WS_WOUT), NP, DM, DM}; pg8::StaticOrder S; S.init(NP, DM, C.G, bx);
        Epi<E_RESIDN> E{}; E.f0 = X; E.b0 = X; E.b1 = X + (size_t)NP * DM; E.scale = 1.0f;
        E.an = Abuf; E.gn = (const float*)args.in[26]; E.rsp = (float*)(ws + WS_RSP + RSP_TAB);
        pg8::gemm_phase<Epi<E_RESIDN>, pg8::StaticOrder, true, true>(C.lds, g, S, E);
        gemm_small(C, (const bf16*)(ws + WS_MRG), (const bf16*)(ws + WS_WOUT), DM, DM, E); }
    }
    GRID_BAR();
    if (PH(13)) {
    {   pg8::Gemm g{Abuf, (const bf16*)(ws + WS_W2GU), MT, NGU, DM}; pg8::StaticOrder S; S.init(MT, NGU, C.G, bx);
        Epi<E_SWIGLUN> E{}; E.o0 = H; E.ldc = DFF; E.xch = C.lds + XCH_OFF; E.ord = 0;
        fill_rowscale(C, S, (const float*)(ws + WS_RSP + RSP_TAB));
        pg8::gemm_phase<Epi<E_SWIGLUN>, pg8::StaticOrder, true, true>(C.lds, g, S, E); }
    }
    GRID_BAR();
    if (PH(14)) {
    {   pg8::Gemm g{H, (const bf16*)(ws + WS_W2D), NP, DM, DFF}; pg8::StaticOrder S; S.init(NP, DM, C.G, bx);
        Epi<E_RESID> E{}; E.f0 = X; E.b0 = X; E.b1 = X + (size_t)NP * DM; E.scale = 0.5f;
        pg8::gemm_phase<Epi<E_RESID>, pg8::StaticOrder, true, true>(C.lds, g, S, E);
        gemm_small(C, H, (const bf16*)(ws + WS_W2D), DM, DFF, E); }
    }
#undef GRID_BAR
}

extern "C" void kernel_launch(void* const* d_in, const int* in_sizes, int n_in, void* d_out, int out_size, void* d_ws, size_t ws_size, hipStream_t stream) {
    static int grid = 0;
    if (grid == 0) {
        if (n_in != 30 || (size_t)out_size != OUT_END || ws_size < WS_END) { fprintf(stderr, "kernel_launch: unexpected shapes (n_in %d, out %d, ws %zu; need ws >= %zu)\n", n_in, out_size, ws_size, (size_t)WS_END); grid = -1; return; }
        int dev = 0, cus = 0, per_cu = 0;
        if (hipGetDevice(&dev) != hipSuccess || hipDeviceGetAttribute(&cus, hipDeviceAttributeMultiprocessorCount, dev) != hipSuccess) { grid = -1; return; }
        if (hipFuncSetAttribute((const void*)fused_fwd, hipFuncAttributeMaxDynamicSharedMemorySize, LDS_BYTES) != hipSuccess) { fprintf(stderr, "kernel_launch: hipFuncSetAttribute failed\n"); grid = -1; return; }
        if (hipOccupancyMaxActiveBlocksPerMultiprocessor(&per_cu, (const void*)fused_fwd, NWAVES * 64, LDS_BYTES) != hipSuccess || per_cu < 1)
            fprintf(stderr, "kernel_launch: note: occupancy query reports %d workgroups per CU\n", per_cu);
        (void)hipGetLastError();
        grid = cus;
    }
    if (grid < 0) return;
    if (hipMemsetAsync((char*)d_ws + WS_CTL + (size_t)CW_BAR * 4, 0, (size_t)XCD_BAR_WORDS * 4, stream) != hipSuccess) { fprintf(stderr, "kernel_launch: memset failed\n"); return; }
    Args a{};
    for (int i = 0; i < 30; ++i) a.in[i] = d_in[i];
    a.out = (float*)d_out; a.ws = (unsigned char*)d_ws;
    hipLaunchKernelGGL(fused_fwd, dim3(grid), dim3(NWAVES * 64), LDS_BYTES, stream, a);
    const hipError_t le = hipPeekAtLastError();
    if (le != hipSuccess) fprintf(stderr, "kernel_launch: launch failed: %s\n", hipGetErrorName(le));
}
```

```cpp
#include <hip/hip_runtime.h>
#include <cstdio>
#include <cstdint>
namespace pg8 {
#define PG8_LAS __attribute__((address_space(3)))
typedef unsigned short bf16_t;
typedef short bf16x8 __attribute__((ext_vector_type(8)));
typedef float f32x4 __attribute__((ext_vector_type(4)));
typedef unsigned u32x4 __attribute__((ext_vector_type(4)));
constexpr int BM = 256, BK = 64, HALF = 128, HTB = HALF * BK * 2  , STAGE_BYTES = 8 * HTB, NXCD = 8, WGM = 8;

__host__ __device__ __forceinline__ int lds_byte(int r, int c) { const int st = (r >> 4) * 2 + (c >> 5), rr = r & 15, cc = c & 31, ob = rr * 64 + cc * 2; return st * 1024 + (ob ^ (((ob >> 9) & 1) << 5)); }
__host__ __device__ __forceinline__ void stage_rc(int b, int& R, int& C) { const int st = b / 1024, sb = b % 1024, swz = sb ^ (((sb >> 9) & 1) << 5); R = (st >> 1) * 16 + swz / 64; C = (st & 1) * 32 + (swz % 64) / 2; }
__host__ __device__ __forceinline__ int perm32(int rho) { const int n = rho >> 4, i = rho & 15; return 8 * (i >> 2) + 4 * n + (i & 3); }

struct Unit { int pm, pn; };
struct Gemm { const bf16_t* A; const bf16_t* Bt; int M, N, K; };

struct StaticOrder {
    int nM, nN, nwg, G, c;
    __host__ __device__ void init(int M, int N, int G_, int c_) { nM = M / BM; nN = N / BM; nwg = nM * nN; G = G_; c = c_; }
    __host__ __device__ __forceinline__ bool next(int i, Unit& u) const { return map((long)i * G + c, u); }
    __host__ __device__ __forceinline__ bool map(long L, Unit& u) const {
        if (L >= nwg) return false;
        int wgid = (int)L; { const int q = nwg / NXCD, r = nwg % NXCD, xcd = wgid % NXCD, off = wgid / NXCD; wgid = (xcd < r ? xcd * (q + 1) : r * (q + 1) + (xcd - r) * q) + off; }
        const int nig = WGM * nN, gid = wgid / nig, fm = gid * WGM, gsz = (nM - fm) < WGM ? (nM - fm) : WGM;
        u.pm = fm + ((wgid % nig) % gsz); u.pn = (wgid % nig) / gsz; return true;
    }
    __device__ __forceinline__ void a_ready(const Unit&) const {}
    __device__ __forceinline__ void done(const Unit&) const {}
};
struct CatOrder {
    StaticOrder S1, S2; int dpm, dpn;
    __device__ __forceinline__ bool next(int i, Unit& u) const {
        const long L = (long)i * S1.G + S1.c;
        if (L < S1.nwg) return S1.map(L, u);
        if (!S2.map(L - S1.nwg, u)) return false;
        u.pm += dpm; u.pn += dpn; return true; }
    __device__ __forceinline__ void a_ready(const Unit&) const {}
    __device__ __forceinline__ void done(const Unit&) const {}
};

__device__ __forceinline__ unsigned cvt_pk_bf16(float lo, float hi) { unsigned r; asm volatile("v_cvt_pk_bf16_f32 %0, %1, %2" : "=v"(r) : "v"(lo), "v"(hi)); return r; }
typedef float f32x2 __attribute__((ext_vector_type(2)));
__device__ __forceinline__ f32x2 gelu_pk(f32x2 v) {
    const f32x2 av = __builtin_elementwise_abs(v), d = av * 0.2316418882f + 1.0f;
    f32x2 t; t.x = __builtin_amdgcn_rcpf(d.x); t.y = __builtin_amdgcn_rcpf(d.y);
    f32x2 q = t * 0.5307027145f + (-0.7265760135f); q = q * t + 0.7107068705f; q = q * t + (-0.142248368f); q = q * t + 0.127414796f; q = q * t;
    const f32x2 s = (v * v) * (-0.72134752044f);
    f32x2 e; e.x = __builtin_amdgcn_exp2f(s.x); e.y = __builtin_amdgcn_exp2f(s.y);
    const f32x2 m = v * (q * e), r = v - m;
    f32x2 o; o.x = v.x < 0.f ? m.x : r.x; o.y = v.y < 0.f ? m.y : r.y; return o;
}

template <class Epi, class Sched, bool ALIGN_EPI = false, bool SP2 = false>
__device__ __forceinline__ void gemm_phase(PG8_LAS unsigned char* lds, const Gemm g, const Sched& S, const Epi& E) {
    int tid_ = threadIdx.x; asm volatile("" : "+v"(tid_));
    const int tid = tid_, wid = __builtin_amdgcn_readfirstlane(tid >> 6), lane = tid & 63, wr = wid >> 2, wc = wid & 3, fr = lane & 15, fq = lane >> 4;
    const int K = g.K, nt = K / BK;
    unsigned voffA[2], voffB[2];
#pragma unroll
    for (int i = 0; i < 2; ++i) { int R, C; stage_rc(tid * 16 + i * 8192, R, C); const int Rb = Epi::PERM ? ((R & ~31) + perm32(R & 31)) : R;
        voffA[i] = (unsigned)(R * K + C) * 2u; voffB[i] = (unsigned)(Rb * K + C) * 2u; }
    const size_t kstep = (size_t)(BK * 2);
    const size_t hstep = (size_t)HALF * K * 2;
    const size_t tstep = 2 * hstep;
    const unsigned ldsw = (unsigned)wid * 1024u;
    const int aoff = lds_byte(wr * 64 + fr, fq * 8), boff = lds_byte(wc * 32 + fr, fq * 8);
#define PG8_SA(b, h) (((b) * 2 + (h)) * HTB)
#define PG8_SB(b, h) ((4 + (b) * 2 + (h)) * HTB)
#define PG8_STAGE(bufoff, gbase, voff) do { _Pragma("unroll") for (int _i = 0; _i < 2; ++_i) \
        __builtin_amdgcn_global_load_lds((const unsigned*)((const char*)(gbase) + (voff)[_i]), (PG8_LAS unsigned*)(lds + (bufoff) + ldsw + _i * 8192), 16, 0, 0); } while (0)
#define PG8_LDA(dst, b, h) do { _Pragma("unroll") for (int m = 0; m < 4; ++m) _Pragma("unroll") for (int k = 0; k < 2; ++k) dst[m][k] = *(const PG8_LAS bf16x8*)(lds + PG8_SA(b, h) + aoff + m * 2048 + k * 1024); } while (0)
#define PG8_LDB(dst, b, h) do { _Pragma("unroll") for (int n = 0; n < 2; ++n) _Pragma("unroll") for (int k = 0; k < 2; ++k) dst[n][k] = *(const PG8_LAS bf16x8*)(lds + PG8_SB(b, h) + boff + n * 2048 + k * 1024); } while (0)
#define PG8_MMA(ai, bj, At, Bt) do { __builtin_amdgcn_s_setprio(1); _Pragma("unroll") for (int m = 0; m < 4; ++m) _Pragma("unroll") for (int n = 0; n < 2; ++n) _Pragma("unroll") for (int k = 0; k < 2; ++k) \
        acc[ai][bj][m][n] = __builtin_amdgcn_mfma_f32_16x16x32_bf16(Bt[n][k], At[m][k], acc[ai][bj][m][n], 0, 0, 0); __builtin_amdgcn_s_setprio(0); } while (0)
#define PG8_WAIT_V(n) asm volatile("s_waitcnt vmcnt(" #n ")" ::: "memory")
#define PG8_WAIT_L(n) asm volatile("s_waitcnt lgkmcnt(" #n ")" ::: "memory")
#define PG8_BAR __builtin_amdgcn_s_barrier()
#define PG8_SCHED __builtin_amdgcn_sched_barrier(0)
    Unit cur, nxt; int ui = 0;
    if (!S.next(0, cur)) return;
    f32x4 acc[2][2][4][2];
#pragma unroll
    for (int a = 0; a < 2; ++a)
#pragma unroll
        for (int b = 0; b < 2; ++b)
#pragma unroll
            for (int m = 0; m < 4; ++m)
#pragma unroll
                for (int n = 0; n < 2; ++n) acc[a][b][m][n] = (f32x4){0.f, 0.f, 0.f, 0.f};
    bf16x8 At[4][2], B0[2][2], B1[2][2];
    const char* cA = (const char*)g.A + (size_t)cur.pm * tstep; const char* cB = (const char*)g.Bt + (size_t)cur.pn * tstep;
    S.a_ready(cur);
    if constexpr (SP2) {
        PG8_STAGE(PG8_SB(0, 0), cB, voffB); PG8_STAGE(PG8_SB(0, 1), cB + hstep, voffB); PG8_STAGE(PG8_SA(0, 0), cA, voffA); PG8_STAGE(PG8_SA(0, 1), cA + hstep, voffA);
        if (wr == 1) PG8_BAR;
        PG8_WAIT_V(2); PG8_BAR;
        PG8_STAGE(PG8_SB(1, 0), cB + kstep, voffB); PG8_STAGE(PG8_SA(1, 0), cA + kstep, voffA); PG8_STAGE(PG8_SB(1, 1), cB + hstep + kstep, voffB);
        PG8_WAIT_V(6); PG8_BAR;
    } else {
        PG8_STAGE(PG8_SB(0, 0), cB, voffB); PG8_STAGE(PG8_SA(0, 0), cA, voffA); PG8_STAGE(PG8_SB(0, 1), cB + hstep, voffB); PG8_STAGE(PG8_SA(0, 1), cA + hstep, voffA);
        if (wr == 1) PG8_BAR;
        PG8_WAIT_V(4); PG8_BAR;
        PG8_STAGE(PG8_SB(1, 0), cB + kstep, voffB); PG8_STAGE(PG8_SA(1, 0), cA + kstep, voffA); PG8_STAGE(PG8_SB(1, 1), cB + hstep + kstep, voffB);
        PG8_WAIT_V(6); PG8_BAR;
    }
    for (;;) {
        const bool has_next = S.next(ui + 1, nxt);
        const char* nA = has_next ? (const char*)g.A + (size_t)nxt.pm * tstep : cA; const char* nB = has_next ? (const char*)g.Bt + (size_t)nxt.pn * tstep : cB;
        for (int t = 0; t < nt; t += 2) {
            const bool last = (t == nt - 2);
            const char* a1 = cA + (size_t)(t + 1) * kstep;
            const char* a2 = last ? nA : cA + (size_t)(t + 2) * kstep; const char* b2 = last ? nB : cB + (size_t)(t + 2) * kstep;
            const char* a3 = a2 + kstep; const char* b3 = b2 + kstep;
            if (last && has_next) S.a_ready(nxt);
            if constexpr (SP2) {
            PG8_LDB(B0, 0, 0); PG8_LDB(B1, 0, 1); PG8_SCHED; PG8_LDA(At, 0, 0); PG8_STAGE(PG8_SA(1, 1), a1 + hstep, voffA);
            PG8_WAIT_V(8); PG8_WAIT_L(0); PG8_BAR; PG8_MMA(0, 0, At, B0); PG8_MMA(0, 1, At, B1); PG8_BAR; PG8_SCHED;
            PG8_LDA(At, 0, 1); PG8_STAGE(PG8_SB(0, 0), b2, voffB); PG8_STAGE(PG8_SB(0, 1), b2 + hstep, voffB); PG8_STAGE(PG8_SA(0, 0), a2, voffA);
            PG8_WAIT_V(8); PG8_WAIT_L(0); PG8_BAR; PG8_MMA(1, 0, At, B0); PG8_MMA(1, 1, At, B1); PG8_BAR; PG8_SCHED;
            PG8_LDB(B0, 1, 0); PG8_LDB(B1, 1, 1); PG8_SCHED; PG8_LDA(At, 1, 0); PG8_STAGE(PG8_SA(0, 1), a2 + hstep, voffA);
            PG8_WAIT_V(8); PG8_WAIT_L(0); PG8_BAR; PG8_MMA(0, 0, At, B0); PG8_MMA(0, 1, At, B1); PG8_BAR; PG8_SCHED;
            PG8_LDA(At, 1, 1); PG8_STAGE(PG8_SB(1, 0), b3, voffB); PG8_STAGE(PG8_SB(1, 1), b3 + hstep, voffB); PG8_STAGE(PG8_SA(1, 0), a3, voffA);
            PG8_WAIT_V(8); PG8_WAIT_L(0); PG8_BAR; PG8_MMA(1, 0, At, B0); PG8_MMA(1, 1, At, B1); PG8_BAR; PG8_SCHED;
            } else {
            PG8_LDB(B0, 0, 0); PG8_SCHED; PG8_LDA(At, 0, 0); PG8_STAGE(PG8_SA(1, 1), a1 + hstep, voffA);
            PG8_WAIT_L(8); PG8_BAR; PG8_WAIT_L(0); PG8_MMA(0, 0, At, B0); PG8_BAR; PG8_SCHED;
            PG8_LDB(B1, 0, 1); PG8_STAGE(PG8_SB(0, 0), b2, voffB);
            PG8_BAR; PG8_WAIT_L(0); PG8_MMA(0, 1, At, B1); PG8_BAR;
            PG8_LDA(At, 0, 1); PG8_STAGE(PG8_SA(0, 0), a2, voffA);
            PG8_BAR; PG8_WAIT_L(0); PG8_MMA(1, 0, At, B0); PG8_BAR; PG8_SCHED;
            PG8_STAGE(PG8_SB(0, 1), b2 + hstep, voffB);
            PG8_WAIT_V(6); PG8_BAR; PG8_MMA(1, 1, At, B1); PG8_BAR;
            PG8_LDB(B0, 1, 0); PG8_SCHED; PG8_LDA(At, 1, 0); PG8_STAGE(PG8_SA(0, 1), a2 + hstep, voffA);
            PG8_WAIT_L(8); PG8_BAR; PG8_WAIT_L(0); PG8_MMA(0, 0, At, B0); PG8_BAR; PG8_SCHED;
            PG8_LDB(B1, 1, 1); PG8_STAGE(PG8_SB(1, 0), b3, voffB);
            PG8_BAR; PG8_WAIT_L(0); PG8_MMA(0, 1, At, B1); PG8_BAR;
            PG8_LDA(At, 1, 1); PG8_STAGE(PG8_SA(1, 0), a3, voffA);
            PG8_BAR; PG8_WAIT_L(0); PG8_MMA(1, 0, At, B0); PG8_BAR; PG8_SCHED;
            PG8_STAGE(PG8_SB(1, 1), b3 + hstep, voffB);
            PG8_WAIT_V(6); PG8_BAR; PG8_MMA(1, 1, At, B1); PG8_BAR;
            }
        }
        if constexpr (ALIGN_EPI) { if (wr == 0) PG8_BAR; }
        if constexpr (!Epi::AFTER_DRAIN) { E(acc, cur, wr, wc, fr, fq); S.done(cur); }
        if (!has_next) break;
#pragma unroll
        for (int a = 0; a < 2; ++a)
#pragma unroll
            for (int b = 0; b < 2; ++b)
#pragma unroll
                for (int m = 0; m < 4; ++m)
#pragma unroll
                    for (int n = 0; n < 2; ++n) acc[a][b][m][n] = (f32x4){0.f, 0.f, 0.f, 0.f};
        cur = nxt; cA = nA; cB = nB; ++ui;
        if constexpr (ALIGN_EPI) { if (wr == 1) PG8_BAR; }
    }
    PG8_WAIT_V(0);
    if constexpr (!ALIGN_EPI) { if (wr == 0) PG8_BAR; }
    PG8_BAR;
    if constexpr (Epi::AFTER_DRAIN) { E.fused(acc, cur, wr, wc, fr, fq, lds, wid, lane); S.done(cur); }
#undef PG8_SA
#undef PG8_SB
#undef PG8_STAGE
#undef PG8_LDA
#undef PG8_LDB
#undef PG8_MMA
#undef PG8_WAIT_V
#undef PG8_WAIT_L
#undef PG8_BAR
#undef PG8_SCHED
}
}
#define LAS __attribute__((address_space(3)))
#define XB_TMO      128
#define XB_XCNT(j)  (256  + 64 * (j))
#define XB_XSUB(j)  (1280 + 64 * (j))
#define XB_XGEN(j)  (2304 + 64 * (j))
#define XB_TOP      3328
#define XB_TOPGEN   3392
#define XCD_BAR_WORDS 3456
#define XB_SPIN_CAP (1u << 18)

__device__ __forceinline__ unsigned xb_ld(unsigned* p)              { return __hip_atomic_load(p, __ATOMIC_RELAXED, __HIP_MEMORY_SCOPE_AGENT); }
__device__ __forceinline__ unsigned xb_add(unsigned* p, unsigned v) { return __hip_atomic_fetch_add(p, v, __ATOMIC_RELAXED, __HIP_MEMORY_SCOPE_AGENT); }
__device__ __forceinline__ unsigned xb_xcc_id() { return (unsigned)__builtin_amdgcn_s_getreg((3 << 11) | 20) & 0xFu; }
#define XB_SPIN(cond, bar) do { unsigned _sp = 0; while (cond) { __builtin_amdgcn_s_sleep(1); \
    if ((++_sp & 255u) == 0u) { if (xb_ld(&(bar)[XB_TMO])) break; if (_sp > XB_SPIN_CAP) { atomicAdd(&(bar)[XB_TMO], 1u); break; } } } } while (0)

struct XcdBarrier {
    unsigned* bar; unsigned x;
    volatile LAS unsigned* st;
};

__device__ __forceinline__ XcdBarrier xcd_barrier_post(unsigned* bar, volatile LAS unsigned* st) {
    XcdBarrier b; b.bar = bar; b.x = xb_xcc_id(); b.st = st;
    if (threadIdx.x == 0) (void)xb_add(&bar[XB_XCNT(b.x)], 1u);
    return b;
}
__device__ __forceinline__ void xcd_barrier_complete(unsigned* bar, unsigned x, unsigned& nloc, unsigned& nx) {
    const unsigned G = gridDim.x * gridDim.y * gridDim.z;
    unsigned sum, cnt, mine, sp = 0u;
    for (;;) {
        sum = 0u; cnt = 0u; mine = 0u;
#pragma unroll
        for (unsigned j = 0; j < 16; ++j) { const unsigned c = xb_ld(&bar[XB_XCNT(j)]); sum += c; cnt += (c > 0u) ? 1u : 0u; mine = (j == x) ? c : mine; }
        if (sum == G) break;
        __builtin_amdgcn_s_sleep(1);
        if ((++sp & 255u) == 0u) { if (xb_ld(&bar[XB_TMO])) break; if (sp > XB_SPIN_CAP) { atomicAdd(&bar[XB_TMO], 1u); break; } }
    }
    nloc = mine > 0u ? mine : 1u; nx = cnt > 0u ? cnt : 1u;
}

__device__ __forceinline__ void xcd_barrier(const XcdBarrier& b) {
    asm volatile("s_waitcnt vmcnt(0)" ::: "memory");
    __syncthreads();
    if (threadIdx.x == 0) {
        unsigned* bar = b.bar;
        __builtin_amdgcn_s_waitcnt(0);
        unsigned nloc = b.st[0], nx = b.st[1];
        if (nloc == 0u) { xcd_barrier_complete(bar, b.x, nloc, nx); b.st[0] = nloc; b.st[1] = nx; }
        const unsigned old = xb_add(&bar[XB_XSUB(b.x)], 1u);
        const unsigned gen = old / nloc;
        if (old + 1u == (gen + 1u) * nloc) {
            __builtin_amdgcn_fence(__ATOMIC_RELEASE, "agent");
            asm volatile("s_waitcnt vmcnt(0)" ::: "memory");
            const unsigned og = xb_add(&bar[XB_TOP], 1u);
            const unsigned tg = og / nx;
            if (og + 1u == (tg + 1u) * nx) xb_add(&bar[XB_TOPGEN], 1u);
            else XB_SPIN(xb_ld(&bar[XB_TOPGEN]) == tg, bar);
            __builtin_amdgcn_fence(__ATOMIC_ACQUIRE, "agent");
            xb_add(&bar[XB_XGEN(b.x)], 1u);
            asm volatile("s_waitcnt vmcnt(0)" ::: "memory");
        } else {
            XB_SPIN(xb_ld(&bar[XB_XGEN(b.x)]) == gen, bar);
            __builtin_amdgcn_fence(__ATOMIC_ACQUIRE, "agent");
            asm volatile("s_waitcnt vmcnt(0)" ::: "memory");
        }
    }
    __syncthreads();
}

#define DI __device__ __forceinline__
typedef float f32x16 __attribute__((ext_vector_type(16)));
typedef float f32x2 __attribute__((ext_vector_type(2)));
typedef unsigned u32x2 __attribute__((ext_vector_type(2)));
typedef short s16x4 __attribute__((ext_vector_type(4)));
typedef short v4i16_t __attribute__((ext_vector_type(4)));
typedef __bf16 bf16x2_t __attribute__((ext_vector_type(2)));

constexpr int DM = 1024, NP = 16384, NS = 1024, MT = NP + NS;
constexpr int DFF = 2816, NGU = 2 * DFF, NIN = 4864, NSM = 768;
constexpr int SEQ = 4096, DEC_B = 128, DEC_T = 8, PAST = 8192, PAGE = 128, NPAGES = 64;
constexpr int NH = 8, DN = 128, DR = 64, DQ = 192, DVH = 128, RL = 256, NQ = NH * DQ;
constexpr int SKEYS = 8448;
constexpr int MR = DEC_B * SKEYS;
constexpr float EPS = 1e-6f;
constexpr float QSCALE = 0.07216878364870322f * 1.4426950408889634f;
constexpr int NWAVES = 8;

constexpr size_t al256(size_t x) { return (x + 255) & ~(size_t)255; }
constexpr size_t WS_CTL = 0, CTL_ZERO_BYTES = 32768;
constexpr size_t WS_W1GU = 1u << 20;
constexpr size_t WS_W1D  = WS_W1GU + al256((size_t)NGU * DM * 2);
constexpr size_t WS_W2GU = WS_W1D + al256((size_t)DM * DFF * 2);
constexpr size_t WS_W2D  = WS_W2GU + al256((size_t)NGU * DM * 2);
constexpr size_t WS_WIN  = WS_W2D + al256((size_t)DM * DFF * 2);
constexpr size_t WS_WUQ  = WS_WIN + al256((size_t)NIN * DM * 2);
constexpr size_t WS_WUKV = WS_WUQ + al256((size_t)NQ * RL * 2);
constexpr size_t WS_WUKO = WS_WUKV + al256((size_t)2048 * RL * 2);
constexpr size_t WS_WOA  = WS_WUKO + al256((size_t)RL * 1024 * 2);
constexpr size_t WS_WOG  = WS_WOA + al256((size_t)DM * DM * 2);
constexpr size_t WS_WOUT = WS_WOG + al256((size_t)DM * DM * 2);
constexpr size_t WS_WST  = WS_WOUT + al256((size_t)DM * DM * 2);
constexpr size_t WS_WF   = WS_WST + al256((size_t)4 * 128 * 128 * 2);
constexpr size_t WS_A    = WS_WF + al256((size_t)RL * 1024 * 2);
constexpr size_t WS_H    = WS_A + al256((size_t)MT * DM * 2);
constexpr size_t WS_SM   = WS_H + al256((size_t)MT * DFF * 2);
constexpr size_t WS_U    = WS_SM + al256((size_t)MT * NSM * 4);
constexpr size_t WS_VG   = WS_U + al256((size_t)MT * DM * 2);
constexpr size_t WS_GA   = WS_VG + al256((size_t)MT * DM * 2);
constexpr size_t WS_GG   = WS_GA + al256((size_t)MT * DM * 2);
constexpr size_t WS_CQN  = WS_GG + al256((size_t)MT * DM * 2);
constexpr size_t WS_LATB = WS_CQN + al256((size_t)MT * RL * 2);
constexpr size_t WS_KRB  = WS_LATB + al256((size_t)MT * RL * 2);
constexpr size_t WS_QN   = WS_KRB + al256((size_t)MT * DR * 2);
constexpr size_t WS_KRAW = WS_QN + al256((size_t)MT * NQ * 2);
constexpr size_t WS_VB   = WS_KRAW + al256((size_t)MT * DM * 2);
constexpr size_t WS_K192 = WS_VB + al256((size_t)MT * DM * 2);
constexpr size_t WS_CB   = WS_K192 + al256((size_t)NP * NQ * 2);
constexpr size_t WS_KRC  = WS_CB + al256((size_t)MR * RL * 2);
constexpr size_t WS_RS   = WS_KRC + al256((size_t)MR * DR * 2);
constexpr size_t WS_PO   = WS_RS + al256((size_t)MR * NH * 4);
constexpr size_t WS_PML  = WS_PO + al256((size_t)256 * 8 * 256 * 32 * 4);
constexpr size_t WS_ATT  = WS_PML + al256((size_t)256 * 8 * 32 * 2 * 4);
constexpr size_t WS_GM   = WS_ATT + al256((size_t)MT * DM * 2);
constexpr size_t WS_M1   = WS_GM + al256((size_t)MT * DM * 2);
constexpr size_t WS_MRG  = WS_M1 + al256((size_t)MT * DM * 4);
constexpr size_t WS_RSP  = WS_MRG + al256((size_t)MT * DM * 2);
constexpr size_t RSP_TAB = ((size_t)NP * 16 + (size_t)NS * 128) * 4;
constexpr size_t WS_END  = WS_RSP + al256(2 * RSP_TAB);
constexpr size_t WS_Q8 = WS_KRAW, WS_K8 = WS_K192;
constexpr int CW_BAR = 4096;

constexpr size_t OUT_X = 0;
constexpr size_t OUT_LATP = (size_t)MT * DM, OUT_ROPEP = OUT_LATP + (size_t)NP * RL, OUT_LATS = OUT_ROPEP + (size_t)NP * DR;
constexpr size_t OUT_ROPES = OUT_LATS + (size_t)NS * RL, OUT_VS = OUT_ROPES + (size_t)NS * DR, OUT_END = OUT_VS + (size_t)NS * DM;

constexpr int RING_BYTES = 131072;
constexpr int XCH_OFF = RING_BYTES;
constexpr int RTAB_OFF = RING_BYTES + 8192;
constexpr int MISC_OFF = 155648;
constexpr int LDS_BYTES = MISC_OFF + 512;

typedef unsigned short bf16;
typedef unsigned v4u __attribute__((ext_vector_type(4)));
using pg8::f32x4; using pg8::bf16x8; using pg8::u32x4;
#define GASP __attribute__((address_space(1)))

DI unsigned f2bf(float f) { unsigned u = __builtin_bit_cast(unsigned, f); return (u + 0x7fffu + ((u >> 16) & 1u)) >> 16; }
DI unsigned pk2(float lo, float hi) { f32x2 v = {lo, hi}; bf16x2_t b = __builtin_convertvector(v, bf16x2_t); return __builtin_bit_cast(unsigned, b); }
DI float bflo(unsigned w) { return __uint_as_float(w << 16); }
DI float bfhi(unsigned w) { return __uint_as_float(w & 0xffff0000u); }
DI float bf2f(bf16 b) { return __uint_as_float((unsigned)b << 16); }
DI float wave_sum(float v) {
#pragma unroll
    for (int o = 1; o < 64; o <<= 1) v += __shfl_xor(v, o);
    return v;
}
DI int crow(int r, int hi) { return (r & 3) + 8 * (r >> 2) + 4 * hi; }
DI float fexp2(float x) { return __builtin_amdgcn_exp2f(x); }
DI float sigmoidf_(float x) { return __builtin_amdgcn_rcpf(1.0f + fexp2(-1.4426950408889634f * x)); }
#define MFMA32(a, b, c) __builtin_amdgcn_mfma_f32_32x32x16_bf16((a), (b), (c), 0, 0, 0)
typedef int v8i_t __attribute__((ext_vector_type(8))); typedef int v4i_t __attribute__((ext_vector_type(4)));
DI unsigned fp8x4(float a, float b, float c, float d) { return (unsigned)__builtin_amdgcn_cvt_pk_fp8_f32(c, d, __builtin_amdgcn_cvt_pk_fp8_f32(a, b, 0, false), true); }
typedef int v2i_t __attribute__((ext_vector_type(2)));
typedef unsigned v6u_t __attribute__((ext_vector_type(6)));
DI v6u_t f6x32(const f32x4 a0, const f32x4 a1, const f32x4 a2, const f32x4 a3, const f32x4 b0, const f32x4 b1, const f32x4 b2, const f32x4 b3, const float sdiv) {
    const f32x16 x0 = {a0[0], a0[1], a0[2], a0[3], a1[0], a1[1], a1[2], a1[3], a2[0], a2[1], a2[2], a2[3], a3[0], a3[1], a3[2], a3[3]};
    const f32x16 x1 = {b0[0], b0[1], b0[2], b0[3], b1[0], b1[1], b1[2], b1[3], b2[0], b2[1], b2[2], b2[3], b3[0], b3[1], b3[2], b3[3]};
    return __builtin_amdgcn_cvt_scalef32_2xpk16_fp6_f32(x0, x1, sdiv);
}
#define MFMA8(a, b, c) __builtin_amdgcn_mfma_scale_f32_32x32x64_f8f6f4((a), (b), (c), 0, 0, 0, 0, 0, 0)
DI s16x4 trread(const LAS unsigned char* p) { return __builtin_bit_cast(s16x4, __builtin_amdgcn_ds_read_tr16_b64_v4i16((LAS v4i16_t*)p)); }
DI bf16x8 cat8(s16x4 lo, s16x4 hi) { return (bf16x8){lo[0], lo[1], lo[2], lo[3], hi[0], hi[1], hi[2], hi[3]}; }
template <int S> DI bf16x8 pack8(const f32x16& x) {
    u32x4 p; p.x = pk2(x[8 * S], x[8 * S + 1]); p.y = pk2(x[8 * S + 2], x[8 * S + 3]); p.z = pk2(x[8 * S + 4], x[8 * S + 5]); p.w = pk2(x[8 * S + 6], x[8 * S + 7]);
    return __builtin_bit_cast(bf16x8, p);
}

DI void rope_cs_fast(int pos, int i, float& cs, float& sn) {
    const float x = (float)pos * exp2f(-(float)i * (13.287712379549449f / 32.0f));
    const float k = rintf(x * 0.15915494309189535f);
    float xr = fmaf(-k, 6.28318548202514648f, x); xr = fmaf(-k, -1.74845553e-07f, xr);
    const float t = xr * 0.15915494309189535f;
    cs = __builtin_amdgcn_cosf(t); sn = __builtin_amdgcn_sinf(t);
}
enum { E_SWIGLU = 0, E_RESID = 1, E_WIN = 2, E_BF16 = 3, E_KV = 4, E_RSQ = 5, E_GATEA = 6, E_GATEB = 7, E_QN = 8, E_KVN = 9, E_RESIDN = 10, E_SWIGLUN = 11, E_QKVN = 12, E_GATEAB = 13 };
constexpr int RSC_OFF = 12288;
template <int MODE> struct Epi {
    static constexpr bool PERM = true, AFTER_DRAIN = false, IS_RESIDN = (MODE == E_RESIDN);
    bf16* o0; bf16* o1; bf16* o2; bf16* o3; float* f0; const float* b0; const float* b1; const bf16* g0; const bf16* g1; int ldc; float scale; LAS unsigned char* xch;
    mutable int ord; bf16* an; const float* gn; float* rsp;
    unsigned char* wsb; float* outp;
    DI void operator()(const f32x4 (&acc)[2][2][4][2], const pg8::Unit& u, int wr, int wc, int fr, int fq) const {
        const int rowb = u.pm * 256 + wr * 64 + fr, colb = u.pn * 256 + wc * 32 + 8 * fq;
        if constexpr (MODE == E_QN || MODE == E_KVN || MODE == E_QKVN) {
            const bool isq = (MODE == E_QN) || (MODE == E_QKVN && u.pn < 6);
            const int pmv = (MODE == E_QKVN && !isq) ? u.pm - MT / 256 : u.pm;
            const int pn = (MODE == E_QKVN && !isq) ? u.pn - 6 : u.pn;
            const int rowb2 = pmv * 256 + wr * 64 + fr;
            if (!isq && pn >= 4) {
#pragma unroll
                for (int ai = 0; ai < 2; ++ai)
#pragma unroll
                    for (int m = 0; m < 4; ++m) { const int row = rowb2 + ai * 128 + m * 16; if (row < NP) {
#pragma unroll
                        for (int bj = 0; bj < 2; ++bj) { const f32x4 a = acc[ai][bj][m][0], b = acc[ai][bj][m][1]; u32x4 w; w.x = pk2(a[0], a[1]); w.y = pk2(a[2], a[3]); w.z = pk2(b[0], b[1]); w.w = pk2(b[2], b[3]);
                            *(u32x4*)((bf16*)(wsb + WS_VB) + (size_t)row * DM + (pn - 4) * 256 + wc * 32 + 8 * fq + bj * 128) = w; } } }
                return;
            }
            LAS float* X = (LAS float*)xch; const LAS float* G = (const LAS float*)(xch + 8192);
#pragma unroll
            for (int ai = 0; ai < 2; ++ai)
#pragma unroll
                for (int m = 0; m < 4; ++m)
#pragma unroll
                    for (int bj = 0; bj < 2; ++bj) {
                        const f32x4 a = acc[ai][bj][m][0], b = acc[ai][bj][m][1];
                        float ss = (a[0] * a[0] + a[1] * a[1]) + (a[2] * a[2] + a[3] * a[3]) + (b[0] * b[0] + b[1] * b[1]) + (b[2] * b[2] + b[3] * b[3]);
                        ss += __shfl_xor(ss, 16); ss += __shfl_xor(ss, 32);
                        if (fq == 0) X[((ai * 128 + wr * 64 + m * 16 + fr) * 2 + bj) * 4 + wc] = ss;
                    }
            asm volatile("s_waitcnt lgkmcnt(0)" ::: "memory"); __builtin_amdgcn_s_barrier(); asm volatile("" ::: "memory");
            const bool ropet = isq && pn >= 4;
#pragma unroll
            for (int ai = 0; ai < 2; ++ai)
#pragma unroll
                for (int m = 0; m < 4; ++m) {
                    const int rt = ai * 128 + wr * 64 + m * 16 + fr, row = pmv * 256 + rt; const bool smp = row >= NP;
                    const int pos = smp ? PAST + ((row - NP) & 7) : (row & (SEQ - 1));
#pragma unroll
                    for (int bj = 0; bj < 2; ++bj) {
                        const f32x4 p = *(const LAS f32x4*)(X + (rt * 2 + bj) * 4);
                        const f32x4 a = acc[ai][bj][m][0], b = acc[ai][bj][m][1];
                        if (!ropet) {
                            const int head = 2 * pn + bj, d0 = wc * 32 + 8 * fq;
                            float r = rsqrtf(((p[0] + p[1]) + (p[2] + p[3])) * (1.0f / DN) + EPS);
                            f32x4 g0_, g1_;
                            if (isq) { r *= QSCALE; g0_ = *(const LAS f32x4*)(G + d0); g1_ = *(const LAS f32x4*)(G + d0 + 4);
                                if (smp) { g0_ = g0_ * *(const LAS f32x4*)(G + 192 + d0); g1_ = g1_ * *(const LAS f32x4*)(G + 192 + d0 + 4); } }
                            else { g0_ = *(const LAS f32x4*)(G + 192 + d0); g1_ = *(const LAS f32x4*)(G + 192 + d0 + 4); }
                            const f32x4 y0 = a * r * g0_, y1 = b * r * g1_;
                            u32x4 w; w.x = pk2(y0[0], y0[1]); w.y = pk2(y0[2], y0[3]); w.z = pk2(y1[0], y1[1]); w.w = pk2(y1[2], y1[3]);
                            if (isq) { if (smp) *(u32x4*)((bf16*)(wsb + WS_QN) + (size_t)row * NQ + head * DQ + d0) = w;
                                       else *(u32x2*)(wsb + WS_Q8 + (size_t)row * NQ + head * DQ + d0) = (u32x2){fp8x4(64.f * y0[0], 64.f * y0[1], 64.f * y0[2], 64.f * y0[3]), fp8x4(64.f * y1[0], 64.f * y1[1], 64.f * y1[2], 64.f * y1[3])}; }
                            else if (!smp) *(u32x2*)(wsb + WS_K8 + (size_t)row * NQ + head * DQ + d0) = (u32x2){fp8x4(y0[0], y0[1], y0[2], y0[3]), fp8x4(y1[0], y1[1], y1[2], y1[3])};
                            else if (wc == 0 && fq == 0) ((float*)(wsb + WS_RS))[((size_t)((row - NP) >> 3) * SKEYS + PAST + ((row - NP) & 7)) * NH + head] = r;
                        } else {
                            const int head = 4 * (pn - 4) + 2 * bj + (wc >> 1), i0 = ((wc & 1) * 4 + fq) * 4;
                            const float r = rsqrtf((wc & 2 ? p[2] + p[3] : p[0] + p[1]) * (1.0f / DR) + EPS);
                            const f32x4 g1v = *(const LAS f32x4*)(G + 128 + i0), g2v = *(const LAS f32x4*)(G + 128 + 32 + i0);
                            float o1[4], o2[4];
#pragma unroll
                            for (int j = 0; j < 4; ++j) { float cs, sn; rope_cs_fast(pos, i0 + j, cs, sn); const float y1 = a[j] * r * g1v[j], y2 = b[j] * r * g2v[j];
                                o1[j] = (y1 * cs - y2 * sn) * QSCALE; o2[j] = (y1 * sn + y2 * cs) * QSCALE; }
                            if (smp) { bf16* qp = (bf16*)(wsb + WS_QN) + (size_t)row * NQ + head * DQ + DN + i0;
                                u32x2 w1; w1.x = pk2(o1[0], o1[1]); w1.y = pk2(o1[2], o1[3]); *(u32x2*)qp = w1;
                                u32x2 w2; w2.x = pk2(o2[0], o2[1]); w2.y = pk2(o2[2], o2[3]); *(u32x2*)(qp + 32) = w2; }
                            else { unsigned char* qp = wsb + WS_Q8 + (size_t)row * NQ + head * DQ + DN + i0;
                                *(unsigned*)qp = fp8x4(64.f * o1[0], 64.f * o1[1], 64.f * o1[2], 64.f * o1[3]); *(unsigned*)(qp + 32) = fp8x4(64.f * o2[0], 64.f * o2[1], 64.f * o2[2], 64.f * o2[3]); }
                        }
                    }
                }
            return;
        }
        if constexpr (MODE == E_WIN) {
            const int pn = u.pn; const bool isv = pn >= 6 && pn < 10, normed = pn < 2 || isv;
            float rsc[2][4];
#pragma unroll
            for (int ai = 0; ai < 2; ++ai)
#pragma unroll
                for (int m = 0; m < 4; ++m) rsc[ai][m] = *(const LAS float*)(xch + RSC_OFF + (ord * 256 + ai * 128 + wr * 64 + m * 16 + fr) * 4);
            ++ord;
            if (!normed) {
                const int sec = (pn - 2) >> 2;
                bf16* ob0 = (bf16*)(wsb + (sec == 0 ? WS_U : sec == 2 ? WS_GA : WS_GG));
                const int c0 = colb - 512 - sec * 1024;
#pragma unroll
                for (int ai = 0; ai < 2; ++ai)
#pragma unroll
                    for (int m = 0; m < 4; ++m)
#pragma unroll
                        for (int bj = 0; bj < 2; ++bj) {
                            f32x4 a = acc[ai][bj][m][0] * rsc[ai][m], b = acc[ai][bj][m][1] * rsc[ai][m];
                            if (sec == 0) { const f32x2 g0_ = pg8::gelu_pk((f32x2){a[0], a[1]}), g1_ = pg8::gelu_pk((f32x2){a[2], a[3]}), g2_ = pg8::gelu_pk((f32x2){b[0], b[1]}), g3_ = pg8::gelu_pk((f32x2){b[2], b[3]});
                                a = (f32x4){g0_.x, g0_.y, g1_.x, g1_.y}; b = (f32x4){g2_.x, g2_.y, g3_.x, g3_.y}; }
                            else {
#pragma unroll
                                for (int j = 0; j < 4; ++j) { a[j] = sigmoidf_(a[j]); b[j] = sigmoidf_(b[j]); } }
                            u32x4 w; w.x = pk2(a[0], a[1]); w.y = pk2(a[2], a[3]); w.z = pk2(b[0], b[1]); w.w = pk2(b[2], b[3]);
                            *(u32x4*)(ob0 + (size_t)(rowb + ai * 128 + m * 16) * DM + c0 + bj * 128) = w;
                        }
                return;
            }
            LAS float* X = (LAS float*)xch; const LAS float* G = (const LAS float*)(xch + 4096) + (pn < 2 ? pn * 256 : 512 + (pn - 6) * 256);
            f32x4 (&W_)[2][2][4][2] = const_cast<f32x4 (&)[2][2][4][2]>(acc);
#pragma unroll
            for (int ai = 0; ai < 2; ++ai)
#pragma unroll
                for (int m = 0; m < 4; ++m) {
                    float ss = 0.f;
#pragma unroll
                    for (int bj = 0; bj < 2; ++bj) {
                        f32x4 a = acc[ai][bj][m][0] * rsc[ai][m], b = acc[ai][bj][m][1] * rsc[ai][m];
                        if (isv) { const f32x2 g0_ = pg8::gelu_pk((f32x2){a[0], a[1]}), g1_ = pg8::gelu_pk((f32x2){a[2], a[3]}), g2_ = pg8::gelu_pk((f32x2){b[0], b[1]}), g3_ = pg8::gelu_pk((f32x2){b[2], b[3]});
                            a = (f32x4){g0_.x, g0_.y, g1_.x, g1_.y}; b = (f32x4){g2_.x, g2_.y, g3_.x, g3_.y}; }
                        W_[ai][bj][m][0] = a; W_[ai][bj][m][1] = b;
                        ss += (a[0] * a[0] + a[1] * a[1]) + (a[2] * a[2] + a[3] * a[3]) + (b[0] * b[0] + b[1] * b[1]) + (b[2] * b[2] + b[3] * b[3]);
                    }
                    ss += __shfl_xor(ss, 16); ss += __shfl_xor(ss, 32);
                    if (fq == 0) X[(ai * 128 + wr * 64 + m * 16 + fr) * 4 + wc] = ss;
                }
            asm volatile("s_waitcnt lgkmcnt(0)" ::: "memory"); __builtin_amdgcn_s_barrier(); asm volatile("" ::: "memory");
            const int cl = wc * 32 + 8 * fq;
#pragma unroll
            for (int ai = 0; ai < 2; ++ai)
#pragma unroll
                for (int m = 0; m < 4; ++m) {
                    const int rt = ai * 128 + wr * 64 + m * 16 + fr, row = u.pm * 256 + rt;
                    const f32x4 p = *(const LAS f32x4*)(X + rt * 4);
                    const float r = rsqrtf(((p[0] + p[1]) + (p[2] + p[3])) * (1.0f / 256.0f) + EPS);
#pragma unroll
                    for (int bj = 0; bj < 2; ++bj) {
                        const int c = cl + bj * 128;
                        const f32x4 g0_ = *(const LAS f32x4*)(G + c), g1_ = *(const LAS f32x4*)(G + c + 4);
                        const f32x4 y0 = W_[ai][bj][m][0] * r * g0_, y1 = W_[ai][bj][m][1] * r * g1_;
                        u32x4 w; w.x = pk2(y0[0], y0[1]); w.y = pk2(y0[2], y0[3]); w.z = pk2(y1[0], y1[1]); w.w = pk2(y1[2], y1[3]);
                        if (pn == 0) *(u32x4*)((bf16*)(wsb + WS_CQN) + (size_t)row * RL + c) = w;
                        else if (pn == 1) {
                            *(u32x4*)((bf16*)(wsb + WS_LATB) + (size_t)row * RL + c) = w;
                            float* op = (row < NP ? outp + OUT_LATP + (size_t)row * RL : outp + OUT_LATS + (size_t)(row - NP) * RL) + c;
                            *(f32x4*)op = y0; *(f32x4*)(op + 4) = y1;
                        } else {
                            *(u32x4*)((bf16*)(wsb + WS_VG) + (size_t)row * DM + (pn - 6) * 256 + c) = w;
                            if (row >= NP) { float* op = outp + OUT_VS + (size_t)(row - NP) * DM + (pn - 6) * 256 + c; *(f32x4*)op = y0; *(f32x4*)(op + 4) = y1; }
                        }
                    }
                }
            return;
        }
        if constexpr (MODE == E_RSQ) {
            LAS float* X = (LAS float*)xch;
#pragma unroll
            for (int ai = 0; ai < 2; ++ai)
#pragma unroll
                for (int m = 0; m < 4; ++m)
#pragma unroll
                    for (int bj = 0; bj < 2; ++bj) {
                        const f32x4 a = acc[ai][bj][m][0], b = acc[ai][bj][m][1];
                        float ss = (a[0] * a[0] + a[1] * a[1]) + (a[2] * a[2] + a[3] * a[3]) + (b[0] * b[0] + b[1] * b[1]) + (b[2] * b[2] + b[3] * b[3]);
                        ss += __shfl_xor(ss, 16); ss += __shfl_xor(ss, 32);
                        if (fq == 0) X[(ai * 128 + wr * 64 + m * 16 + fr) * 8 + bj * 4 + wc] = ss;
                    }
            asm volatile("s_waitcnt lgkmcnt(0)" ::: "memory"); __builtin_amdgcn_s_barrier(); asm volatile("" ::: "memory");
            const int tid = threadIdx.x, rt = tid >> 1, hd = tid & 1;
            const f32x4 p = *(const LAS f32x4*)(X + rt * 8 + hd * 4);
            const float s = (p[0] + p[1]) + (p[2] + p[3]);
            f0[(size_t)(u.pm * 256 + rt) * 8 + u.pn * 2 + hd] = rsqrtf(s * (1.0f / 128.0f) + EPS);
            return;
        }
#pragma unroll
        for (int ai = 0; ai < 2; ++ai)
#pragma unroll
            for (int m = 0; m < 4; ++m) {
                const int row = rowb + ai * 128 + m * 16;
                const float rs = (MODE == E_SWIGLUN) ? *(const LAS float*)(xch + RSC_OFF + (ord * 256 + ai * 128 + wr * 64 + m * 16 + fr) * 4) : 1.0f;
                float ss = 0.f;
#pragma unroll
                for (int bj = 0; bj < 2; ++bj) ss += store8(row, colb + bj * 128, u.pn, acc[ai][bj][m][0] * rs, acc[ai][bj][m][1] * rs);
                if constexpr (MODE == E_RESIDN) { ss += __shfl_xor(ss, 16); ss += __shfl_xor(ss, 32); if (fq == 0) rsp[(size_t)row * 16 + u.pn * 4 + wc] = ss; }
            }
        if constexpr (MODE == E_SWIGLUN) ++ord;
    }
    DI float store8(int row, int col, int pn, const f32x4 v0, const f32x4 v1) const {
                    if constexpr (MODE == E_SWIGLU || MODE == E_SWIGLUN) {
                        u32x2 w; float h[4];
#pragma unroll
                        for (int j = 0; j < 4; ++j) h[j] = v0[j] * sigmoidf_(v0[j]) * v1[j];
                        w.x = pk2(h[0], h[1]); w.y = pk2(h[2], h[3]);
                        *(u32x2*)(o0 + (size_t)row * ldc + (col >> 1)) = w;
                    } else if constexpr (MODE == E_RESID) {
                        const float* bp = (row < NP ? b0 + (size_t)row * DM : b1 + (size_t)(row - NP) * DM) + col;
                        float* op = f0 + (size_t)row * DM + col;
                        const f32x4 x0 = *(const f32x4*)bp, x1 = *(const f32x4*)(bp + 4);
                        *(f32x4*)op = x0 + v0 * scale; *(f32x4*)(op + 4) = x1 + v1 * scale;
                    } else if constexpr (MODE == E_RESIDN) {
                        const float* bp = (row < NP ? b0 + (size_t)row * DM : b1 + (size_t)(row - NP) * DM) + col;
                        float* op = f0 + (size_t)row * DM + col;
                        const f32x4 x0 = *(const f32x4*)bp, x1 = *(const f32x4*)(bp + 4);
                        const f32x4 y0 = x0 + v0 * scale, y1 = x1 + v1 * scale;
                        *(f32x4*)op = y0; *(f32x4*)(op + 4) = y1;
                        const f32x4 g0_ = *(const f32x4*)(gn + col), g1_ = *(const f32x4*)(gn + col + 4);
                        u32x4 w; w.x = pk2(y0[0] * g0_[0], y0[1] * g0_[1]); w.y = pk2(y0[2] * g0_[2], y0[3] * g0_[3]); w.z = pk2(y1[0] * g1_[0], y1[1] * g1_[1]); w.w = pk2(y1[2] * g1_[2], y1[3] * g1_[3]);
                        *(u32x4*)(an + (size_t)row * DM + col) = w;
                        return (y0[0] * y0[0] + y0[1] * y0[1]) + (y0[2] * y0[2] + y0[3] * y0[3]) + (y1[0] * y1[0] + y1[1] * y1[1]) + (y1[2] * y1[2] + y1[3] * y1[3]);
                    } else if constexpr (MODE == E_WIN) {
                        if (pn < 3) {
                            float* op = f0 + (size_t)row * NSM + col;
                            *(f32x4*)op = v0; *(f32x4*)(op + 4) = v1;
                        } else {
                            const int sec = (pn - 3) >> 2, c = col - 768 - sec * 1024;
                            bf16* ob = (sec == 0 ? o0 : sec == 1 ? o1 : sec == 2 ? o2 : o3) + (size_t)row * DM + c;
                            f32x4 a = v0, b = v1;
                            if (sec < 2) {
                                const f32x2 g0_ = pg8::gelu_pk((f32x2){a[0], a[1]}), g1_ = pg8::gelu_pk((f32x2){a[2], a[3]}), g2_ = pg8::gelu_pk((f32x2){b[0], b[1]}), g3_ = pg8::gelu_pk((f32x2){b[2], b[3]});
                                a = (f32x4){g0_.x, g0_.y, g1_.x, g1_.y}; b = (f32x4){g2_.x, g2_.y, g3_.x, g3_.y};
                            } else {
#pragma unroll
                                for (int j = 0; j < 4; ++j) { a[j] = sigmoidf_(a[j]); b[j] = sigmoidf_(b[j]); }
                            }
                            u32x4 w; w.x = pk2(a[0], a[1]); w.y = pk2(a[2], a[3]); w.z = pk2(b[0], b[1]); w.w = pk2(b[2], b[3]);
                            *(u32x4*)ob = w;
                        }
                    } else if constexpr (MODE == E_BF16) {
                        u32x4 w; w.x = pk2(v0[0], v0[1]); w.y = pk2(v0[2], v0[3]); w.z = pk2(v1[0], v1[1]); w.w = pk2(v1[2], v1[3]);
                        *(u32x4*)(o0 + (size_t)row * ldc + col) = w;
                    } else if constexpr (MODE == E_KV) {
                        u32x4 w; w.x = pk2(v0[0], v0[1]); w.y = pk2(v0[2], v0[3]); w.z = pk2(v1[0], v1[1]); w.w = pk2(v1[2], v1[3]);
                        bf16* ob = (pn < 4 ? o0 + col : o1 + (col - 1024)) + (size_t)row * DM;
                        *(u32x4*)ob = w;
                    } else if constexpr (MODE == E_GATEAB) {
                        if (pn < 4) {
                            const u32x4 g = *(const u32x4*)(g0 + (size_t)row * DM + col);
                            float* op = f0 + (size_t)row * DM + col;
                            *(f32x4*)op = (f32x4){v0[0] * bflo(g.x), v0[1] * bfhi(g.x), v0[2] * bflo(g.y), v0[3] * bfhi(g.y)};
                            *(f32x4*)(op + 4) = (f32x4){v1[0] * bflo(g.z), v1[1] * bfhi(g.z), v1[2] * bflo(g.w), v1[3] * bfhi(g.w)};
                        } else {
                            const int r2 = row - MT, c2 = col - 1024;
                            const u32x4 g = *(const u32x4*)(g1 + (size_t)r2 * DM + c2);
                            const float* mp = f0 + (size_t)r2 * DM + c2;
                            const f32x4 m0 = *(const f32x4*)mp, m1_ = *(const f32x4*)(mp + 4);
                            u32x4 w;
                            w.x = pk2(m0[0] + v0[0] * bflo(g.x), m0[1] + v0[1] * bfhi(g.x)); w.y = pk2(m0[2] + v0[2] * bflo(g.y), m0[3] + v0[3] * bfhi(g.y));
                            w.z = pk2(m1_[0] + v1[0] * bflo(g.z), m1_[1] + v1[1] * bfhi(g.z)); w.w = pk2(m1_[2] + v1[2] * bflo(g.w), m1_[3] + v1[3] * bfhi(g.w));
                            *(u32x4*)(o0 + (size_t)r2 * DM + c2) = w;
                        }
                    } else if constexpr (MODE == E_GATEA) {
                        const u32x4 g = *(const u32x4*)(g0 + (size_t)row * DM + col);
                        float* op = f0 + (size_t)row * DM + col;
                        *(f32x4*)op = (f32x4){v0[0] * bflo(g.x), v0[1] * bfhi(g.x), v0[2] * bflo(g.y), v0[3] * bfhi(g.y)};
                        *(f32x4*)(op + 4) = (f32x4){v1[0] * bflo(g.z), v1[1] * bfhi(g.z), v1[2] * bflo(g.w), v1[3] * bfhi(g.w)};
                    } else if constexpr (MODE == E_GATEB) {
                        const u32x4 g = *(const u32x4*)(g0 + (size_t)row * DM + col);
                        const float* mp = f0 + (size_t)row * DM + col;
                        const f32x4 m0 = *(const f32x4*)mp, m1 = *(const f32x4*)(mp + 4);
                        u32x4 w;
                        w.x = pk2(m0[0] + v0[0] * bflo(g.x), m0[1] + v0[1] * bfhi(g.x)); w.y = pk2(m0[2] + v0[2] * bflo(g.y), m0[3] + v0[3] * bfhi(g.y));
                        w.z = pk2(m1[0] + v1[0] * bflo(g.z), m1[1] + v1[1] * bfhi(g.z)); w.w = pk2(m1[2] + v1[2] * bflo(g.w), m1[3] + v1[3] * bfhi(g.w));
                        *(u32x4*)(o0 + (size_t)row * DM + col) = w;
                    }
        return 0.f;
    }
};

struct Args { const void* in[30]; float* out; unsigned char* ws; };
struct Ctx {
    LAS unsigned char* lds; int tid, lane, wave, vcu, G;
    const Args* a;
};

DI int dest_row(int mode, int n) {
    if (mode == 5) { const int head = n / DQ, d = n - head * DQ; if (d < DN) return head * DN + d; const int q = d - DN, half = q >> 5, i = q & 31; return 1024 + head * 64 + 8 * (i >> 2) + 4 * half + (i & 3); }
    return mode == 0 ? n : mode == 1 ? 8 * (n >> 2) + (n & 3) : mode == 2 ? 8 * (n >> 2) + 4 + (n & 3) : mode == 3 ? (n < 512 ? n : n < 576 ? 4608 + (n - 512) : n - 64) : n + 1024;
}
DI void p0_transpose_item(const float* W, int K, int N, bf16* WT, int mode, LAS float* scr, int item, int lane) {
    const int nblk = N / 32, kb = item / nblk, nb = item % nblk, k0 = 64 * kb, n0 = 32 * nb;
#pragma unroll 8
    for (int i = 0; i < 32; ++i) { const int kk = 2 * i + (lane >> 5); scr[kk * 33 + (lane & 31)] = W[(size_t)(k0 + kk) * N + n0 + (lane & 31)]; }
    asm volatile("s_waitcnt lgkmcnt(0)" ::: "memory");
    const int c = lane & 7;
#pragma unroll
    for (int j = 0; j < 4; ++j) { const int n = (lane >> 3) + 8 * j; const LAS float* s = scr + (8 * c) * 33 + n;
        v4u o; o.x = pk2(s[0 * 33], s[1 * 33]); o.y = pk2(s[2 * 33], s[3 * 33]); o.z = pk2(s[4 * 33], s[5 * 33]); o.w = pk2(s[6 * 33], s[7 * 33]);
        *(v4u*)(WT + (size_t)dest_row(mode, n0 + n) * K + k0 + 8 * c) = o; }
    asm volatile("s_waitcnt lgkmcnt(0)" ::: "memory");
}
DI void rms_row_1024(const float* xrow, const float* g, bf16* orow, int lane) {
    const f32x4* xr = (const f32x4*)xrow + lane; const f32x4* gr = (const f32x4*)g + lane;
    f32x4 v[4]; float s = 0.f;
#pragma unroll
    for (int j = 0; j < 4; ++j) { v[j] = xr[64 * j]; s += (v[j][0] * v[j][0] + v[j][1] * v[j][1]) + (v[j][2] * v[j][2] + v[j][3] * v[j][3]); }
    const float r = rsqrtf(wave_sum(s) * (1.f / DM) + EPS);
    u32x2* o8 = (u32x2*)orow + lane;
#pragma unroll
    for (int j = 0; j < 4; ++j) { const f32x4 gg = gr[64 * j]; u32x2 w; w.x = pk2(v[j][0] * r * gg[0], v[j][1] * r * gg[1]); w.y = pk2(v[j][2] * r * gg[2], v[j][3] * r * gg[3]); o8[64 * j] = w; }
}
DI void p0_prologue(const Ctx& C) {
    const Args& A = *C.a; unsigned char* ws = A.ws; int tid_ = threadIdx.x; asm volatile("" : "+v"(tid_)); const int lane = tid_ & 63;
    LAS float* scr = (LAS float*)(C.lds + C.wave * 16384);
    const int gw = C.vcu * NWAVES + C.wave, NGW = C.G * NWAVES;
    constexpr int I_G = (DM / 64) * (DFF / 32), I_D = (DFF / 64) * (DM / 32), I_IN = (DM / 64) * (4672 / 32), I_UQ = (RL / 64) * (NQ / 32), I_UK = (RL / 64) * (1024 / 32), I_SQ = (DM / 64) * (DM / 32);
    constexpr int NITEMS = 4 * I_G + 2 * I_D + I_IN + I_UQ + 2 * I_UK + 3 * I_SQ;
    for (int it = gw; it < NITEMS; it += NGW) {
        int r = it;
#define TR_(idx, K_, N_, off, mode, NI) if (r < (NI)) { p0_transpose_item((const float*)A.in[idx], K_, N_, (bf16*)(ws + (off)), mode, scr, r, lane); continue; } r -= (NI);
        TR_(6, DM, DFF, WS_W1GU, 1, I_G)
        TR_(7, DM, DFF, WS_W1GU, 2, I_G)
        TR_(8, DFF, DM, WS_W1D, 0, I_D)
        TR_(27, DM, DFF, WS_W2GU, 1, I_G)
        TR_(28, DM, DFF, WS_W2GU, 2, I_G)
        TR_(29, DFF, DM, WS_W2D, 0, I_D)
        TR_(10, DM, 4672, WS_WIN, 3, I_IN)
        TR_(12, RL, NQ, WS_WUQ, 5, I_UQ)
        TR_(14, RL, 1024, WS_WUKV, 0, I_UK)
        TR_(15, RL, 1024, WS_WUKV, 4, I_UK)
        TR_(23, DM, DM, WS_WOA, 0, I_SQ)
        TR_(24, DM, DM, WS_WOG, 0, I_SQ)
        TR_(25, DM, DM, WS_WOUT, 0, I_SQ)
#undef TR_
    }
    const int gt = gw * 64 + lane, NGT = NGW * 64;
    { const float* wuk = (const float*)A.in[14]; bf16* o = (bf16*)(ws + WS_WUKO);
      for (int i = gt; i < RL * 1024 / 4; i += NGT) { const f32x4 v = ((const f32x4*)wuk)[i]; u32x2 w; w.x = pk2(v[0], v[1]); w.y = pk2(v[2], v[3]); ((u32x2*)o)[i] = w; } }
    { const float* wsrc = (const float*)A.in[21]; bf16* o = (bf16*)(ws + WS_WST);
      for (int i = gt; i < 4 * 128 * 128; i += NGT) { const int t = (i >> 7) & 127, s = i & 127; o[i] = (bf16)f2bf(s <= t ? wsrc[i] : 0.f); } }
    {
        const float* wuk = (const float*)A.in[14]; unsigned char* wf = ws + WS_WF;
        for (int i = gt; i < 8 * 4 * 4 * 64; i += NGT) {
            const int ln = i & 63, s = (i >> 6) & 3, db = (i >> 8) & 3, h = i >> 10;
            const int g = 2 * s + (ln >> 5);
            const float* q = wuk + (size_t)(8 * g) * 1024 + h * 128 + 32 * db + (ln & 31);
            f32x4 ra[4], rb[4];
#pragma unroll
            for (int k = 0; k < 4; ++k)
#pragma unroll
                for (int b = 0; b < 4; ++b) { ra[k][b] = q[(size_t)(64 * k + b) * 1024]; rb[k][b] = q[(size_t)(64 * k + 4 + b) * 1024]; }
            const v6u_t o = f6x32(ra[0], ra[1], ra[2], ra[3], rb[0], rb[1], rb[2], rb[3], 1.f / 32.f);
            unsigned char* fb = wf + (size_t)(i >> 6) * 1536;
            *(v4u*)(fb + ln * 16) = (v4u){o[0], o[1], o[2], o[3]};
            *(u32x2*)(fb + 1024 + ln * 8) = (u32x2){o[4], o[5]};
        }
    }
    for (int m = gw; m < MT; m += NGW) {
        const float* xr = m < NP ? (const float*)A.in[0] + (size_t)m * DM : (const float*)A.in[1] + (size_t)(m - NP) * DM;
        rms_row_1024(xr, (const float*)A.in[5], (bf16*)(ws + WS_A) + (size_t)m * DM, lane);
    }
}

template <class EpiT> DI void gemm_small(const Ctx& C, const bf16* A, const bf16* Bt, int N, int K, const EpiT& E) {
    LAS float* red = (LAS float*)C.lds;
    int tid_ = threadIdx.x; asm volatile("" : "+v"(tid_)); const int tid = tid_, lane = tid & 63, wid = C.wave, n = lane & 31, hh = lane >> 5;
    const int ntn = N >> 6, nitems = (NS >> 6) * ntn, kw = K >> 3, nch = kw >> 5;
    LAS unsigned char* stg = C.lds + wid * 16384;
    const int drow = lane >> 2, dc = (lane & 3) ^ ((drow >> 2) & 3);
    const int roff = (n >> 4) * 1024 + (n & 15) * 64, rx = (n >> 2) & 3;
    const size_t rstep = (size_t)16 * K * 2;
    for (int it = C.vcu; it < nitems; it += C.G) {
        int tm = it / ntn, tn = it - tm * ntn;
        if (nitems == 256 && C.G == 256 && ntn == 16) { const int x = it >> 5, l = it & 31; tm = 4 * (x >> 1) + (l >> 3); tn = 8 * (x & 1) + (l & 7); }
        const int row0 = NP + tm * 64, col0 = tn * 64;
        __syncthreads();
        f32x16 acc[2][2];
#pragma unroll
        for (int i = 0; i < 2; ++i)
#pragma unroll
            for (int j = 0; j < 2; ++j)
#pragma unroll
                for (int r = 0; r < 16; ++r) acc[i][j][r] = 0.f;
        const char* ag = (const char*)(A + (size_t)(row0 + drow) * K + wid * kw) + dc * 16; const char* bg = (const char*)(Bt + (size_t)(col0 + drow) * K + wid * kw) + dc * 16;
#define GS_STAGE(buf_, ch_) do { _Pragma("unroll") for (int j = 0; j < 4; ++j) { \
            __builtin_amdgcn_global_load_lds((const unsigned*)(ag + j * rstep + (size_t)(ch_) * 64), (LAS unsigned*)(stg + (buf_) * 8192 + j * 1024), 16, 0, 0); \
            __builtin_amdgcn_global_load_lds((const unsigned*)(bg + j * rstep + (size_t)(ch_) * 64), (LAS unsigned*)(stg + (buf_) * 8192 + 4096 + j * 1024), 16, 0, 0); } } while (0)
        GS_STAGE(0, 0);
#pragma nounroll
        for (int ch = 0; ch < nch; ++ch) {
            if (ch + 1 < nch) { GS_STAGE((ch + 1) & 1, ch + 1); asm volatile("s_waitcnt vmcnt(8)" ::: "memory"); }
            else asm volatile("s_waitcnt vmcnt(0)" ::: "memory");
            const LAS unsigned char* sb = stg + (ch & 1) * 8192 + roff;
            bf16x8 a[2][2], b[2][2];
#pragma unroll
            for (int i = 0; i < 2; ++i)
#pragma unroll
                for (int t = 0; t < 2; ++t) { a[i][t] = *(const LAS bf16x8*)(sb + i * 2048 + (((2 * t + hh) ^ rx) * 16)); b[i][t] = *(const LAS bf16x8*)(sb + 4096 + i * 2048 + (((2 * t + hh) ^ rx) * 16)); }
#pragma unroll
            for (int t = 0; t < 2; ++t) { acc[0][0] = MFMA32(a[0][t], b[0][t], acc[0][0]); acc[0][1] = MFMA32(a[0][t], b[1][t], acc[0][1]); acc[1][0] = MFMA32(a[1][t], b[0][t], acc[1][0]); acc[1][1] = MFMA32(a[1][t], b[1][t], acc[1][1]); }
            asm volatile("s_waitcnt lgkmcnt(0)" ::: "memory");
            __builtin_amdgcn_sched_barrier(0);
        }
#undef GS_STAGE
#pragma unroll
        for (int i = 0; i < 2; ++i)
#pragma unroll
            for (int j = 0; j < 2; ++j)
#pragma unroll
                for (int r = 0; r < 16; ++r) red[wid * 4096 + (32 * i + crow(r, hh)) * 64 + 32 * j + n] = acc[i][j][r];
        __syncthreads();
        const int row = tid >> 3, c8 = (tid & 7) * 8;
        f32x4 v0 = {0.f, 0.f, 0.f, 0.f}, v1 = {0.f, 0.f, 0.f, 0.f};
#pragma unroll
        for (int w = 0; w < 8; ++w) { v0 += *(const LAS f32x4*)(red + w * 4096 + row * 64 + c8); v1 += *(const LAS f32x4*)(red + w * 4096 + row * 64 + c8 + 4); }
        { const float ss = E.store8(row0 + row, col0 + c8, (col0 + c8) >> 8, v0, v1); if constexpr (EpiT::IS_RESIDN) E.rsp[(size_t)NP * 16 + (size_t)(row0 + row - NP) * 128 + tn * 8 + (tid & 7)] = ss; }
    }
    __syncthreads();
}

template <class Sched> DI void fill_rowscale(const Ctx& C, const Sched& S, const float* rsp) {
    int tid_ = threadIdx.x; asm volatile("" : "+v"(tid_)); const int tid = tid_;
    pg8::Unit uu;
    for (int i = 0; i < 8 && S.next(i, uu); ++i) {
        if (tid < 256) {
            const int row = uu.pm * 256 + tid; float ss = 0.f;
            if (row < NP) { const f32x4* p = (const f32x4*)(rsp + (size_t)row * 16);
#pragma unroll
                for (int k = 0; k < 4; ++k) { const f32x4 v = p[k]; ss += (v[0] + v[1]) + (v[2] + v[3]); } }
            else { const f32x4* p = (const f32x4*)(rsp + (size_t)NP * 16 + (size_t)(row - NP) * 128);
#pragma unroll 8
                for (int k = 0; k < 32; ++k) { const f32x4 v = p[k]; ss += (v[0] + v[1]) + (v[2] + v[3]); } }
            *(LAS float*)(C.lds + XCH_OFF + RSC_OFF + (i * 256 + tid) * 4) = rsqrtf(ss * (1.0f / DM) + EPS);
        }
    }
    __syncthreads();
}

DI void rope_angle(int pos, int i, float& cs, float& sn) {
    const float inv = exp2f(-(float)i * (13.287712379549449f / 32.0f));
    const float ang = (float)pos * inv; cs = cosf(ang); sn = sinf(ang);
}
DI void krope_gemm(const Ctx& C) {
    const Args& A_ = *C.a; unsigned char* ws = A_.ws; LAS float* red = (LAS float*)C.lds;
    int tid_ = threadIdx.x; asm volatile("" : "+v"(tid_)); const int tid = tid_, lane = tid & 63, wid = C.wave, n = lane & 31, hh = lane >> 5;
    const bf16* A = (const bf16*)(ws + WS_A); const bf16* Bt = (const bf16*)(ws + WS_WIN) + (size_t)4608 * DM; bf16* KRB = (bf16*)(ws + WS_KRB);
    const float* gkr = (const float*)A_.in[19];
    constexpr int K = DM, kw = K >> 3, nks = kw >> 4;
    static_assert(MT % 68 == 0 && MT / 68 == 256, "k_rope items: 68 rows each, one per workgroup");
    for (int it = C.vcu; it < MT / 68; it += C.G) {
        const int row0 = it * 68;
        f32x16 acc[3][2];
#pragma unroll
        for (int i = 0; i < 3; ++i)
#pragma unroll
            for (int j = 0; j < 2; ++j)
#pragma unroll
                for (int r = 0; r < 16; ++r) acc[i][j][r] = 0.f;
        const bf16* ap = A + (size_t)(row0 + n) * K + wid * kw + 8 * hh; const bf16* bp = Bt + (size_t)n * K + wid * kw + 8 * hh;
        const int r2 = row0 + 64 + n < MT ? row0 + 64 + n : MT - 1; const bf16* ap2 = A + (size_t)r2 * K + wid * kw + 8 * hh;
        const size_t blk = (size_t)32 * K;
#pragma unroll 8
        for (int s = 0; s < nks; ++s) {
            const bf16x8 a0 = *(const bf16x8*)(ap + 16 * s), a1 = *(const bf16x8*)(ap + blk + 16 * s), a2 = *(const bf16x8*)(ap2 + 16 * s), b0 = *(const bf16x8*)(bp + 16 * s), b1 = *(const bf16x8*)(bp + blk + 16 * s);
            acc[0][0] = MFMA32(a0, b0, acc[0][0]); acc[0][1] = MFMA32(a0, b1, acc[0][1]); acc[1][0] = MFMA32(a1, b0, acc[1][0]); acc[1][1] = MFMA32(a1, b1, acc[1][1]);
            acc[2][0] = MFMA32(a2, b0, acc[2][0]); acc[2][1] = MFMA32(a2, b1, acc[2][1]);
        }
        __syncthreads();
#pragma unroll
        for (int i = 0; i < 3; ++i)
#pragma unroll
            for (int j = 0; j < 2; ++j)
#pragma unroll
                for (int r = 0; r < 16; ++r) { const int rr = 32 * i + crow(r, hh); if (rr < 68) red[wid * 4352 + rr * 64 + 32 * j + n] = acc[i][j][r]; }
        __syncthreads();
        for (int rl = tid >> 3; rl < 68; rl += 64) {
        const int c8 = tid & 7, row = row0 + rl;
        f32x4 v0 = {0.f, 0.f, 0.f, 0.f}, v1 = {0.f, 0.f, 0.f, 0.f};
#pragma unroll
        for (int w = 0; w < 8; ++w) { v0 += *(const LAS f32x4*)(red + w * 4352 + rl * 64 + c8 * 8); v1 += *(const LAS f32x4*)(red + w * 4352 + rl * 64 + c8 * 8 + 4); }
        const bool smp = row >= NP;
        {
            const float* rsp = (const float*)(ws + WS_RSP); float ps;
            if (!smp) { const f32x2 p = *(const f32x2*)(rsp + (size_t)row * 16 + c8 * 2); ps = p[0] + p[1]; }
            else { const f32x4* p = (const f32x4*)(rsp + (size_t)NP * 16 + (size_t)(row - NP) * 128 + c8 * 16); ps = 0.f;
#pragma unroll
                for (int k = 0; k < 4; ++k) { const f32x4 q = p[k]; ps += (q[0] + q[1]) + (q[2] + q[3]); } }
            ps += __shfl_xor(ps, 1); ps += __shfl_xor(ps, 2); ps += __shfl_xor(ps, 4);
            const float rx = rsqrtf(ps * (1.0f / DM) + EPS);
            v0 = v0 * rx; v1 = v1 * rx;
        }
        float ss = (v0[0] * v0[0] + v0[1] * v0[1]) + (v0[2] * v0[2] + v0[3] * v0[3]) + (v1[0] * v1[0] + v1[1] * v1[1]) + (v1[2] * v1[2] + v1[3] * v1[3]);
        ss += __shfl_xor(ss, 1); ss += __shfl_xor(ss, 2); ss += __shfl_xor(ss, 4);
        const float r = rsqrtf(ss * (1.0f / DR) + EPS); const int pos = smp ? PAST + ((row - NP) & 7) : (row & (SEQ - 1));
        float y[8], o[8];
#pragma unroll
        for (int j = 0; j < 8; ++j) y[j] = (j < 4 ? v0[j] : v1[j - 4]) * r * gkr[c8 * 8 + j];
#pragma unroll
        for (int j = 0; j < 8; ++j) {
            const float yo = __shfl_xor(y[j], 4);
            float cs, sn; rope_cs_fast(pos, (c8 & 3) * 8 + j, cs, sn);
            o[j] = c8 < 4 ? y[j] * cs - yo * sn : yo * sn + y[j] * cs;
        }
        float* op = (smp ? A_.out + OUT_ROPES + (size_t)(row - NP) * DR : A_.out + OUT_ROPEP + (size_t)row * DR) + c8 * 8;
        *(f32x4*)op = (f32x4){o[0], o[1], o[2], o[3]}; *(f32x4*)(op + 4) = (f32x4){o[4], o[5], o[6], o[7]};
        u32x4 w; w.x = pk2(o[0], o[1]); w.y = pk2(o[2], o[3]); w.z = pk2(o[4], o[5]); w.w = pk2(o[6], o[7]);
        *(u32x4*)(KRB + (size_t)row * DR + c8 * 8) = w;
        if (!smp) { unsigned char* kp = ws + WS_K8 + (size_t)row * NQ + DN + c8 * 8; const u32x2 w8 = (u32x2){fp8x4(o[0], o[1], o[2], o[3]), fp8x4(o[4], o[5], o[6], o[7])};
#pragma unroll
            for (int h = 0; h < NH; ++h) *(u32x2*)(kp + h * DQ) = w8; }
        }
    }
    __syncthreads();
}

DI void p3_norm_rows(const Ctx& C, const float* X, const float* g, bf16* Aout) {
    const int gw = C.vcu * NWAVES + C.wave, NGW = C.G * NWAVES;
    int tid_ = threadIdx.x; asm volatile("" : "+v"(tid_)); const int lane = tid_ & 63;
    for (int m = gw; m < MT; m += NGW) rms_row_1024(X + (size_t)m * DM, g, Aout + (size_t)m * DM, lane);
}

constexpr float SM_SHIFT = 10.0f;
constexpr int PK_PITCH = 400, PV_PITCH = 288, PKB = 64 * PK_PITCH, PVB = 64 * PV_PITCH;
constexpr int PK8_PITCH = 208, PK8B = 64 * PK8_PITCH;
DI void attn_prompt_unit(const Ctx& C, const unsigned char* Q8, const unsigned char* K8, const bf16* VB, bf16* ATT, int b, int h, int qb) {
    LAS unsigned char* lds = C.lds; int tid_ = threadIdx.x; asm volatile("" : "+v"(tid_)); const int tid = tid_, lane = tid & 63, wid = C.wave, n = lane & 31, hi = lane >> 5;
    const size_t row0 = (size_t)b * SEQ; const int qrow = qb * 256 + wid * 32 + n;
    v8i_t qf[3];
    { const unsigned char* qp = Q8 + (row0 + qrow) * NQ + h * DQ + 32 * hi;
#pragma unroll
      for (int s = 0; s < 3; ++s) qf[s] = __builtin_shufflevector(*(const v4i_t*)(qp + 64 * s), *(const v4i_t*)(qp + 64 * s + 16), 0, 1, 2, 3, 4, 5, 6, 7); }
    f32x16 O[4];
#pragma unroll
    for (int d = 0; d < 4; ++d)
#pragma unroll
        for (int r = 0; r < 16; ++r) O[d][r] = 0.f;
    float lrun = 0.f;
    const int NT = 4 * (qb + 1);
    unsigned kgo[2], klo[2], vgo[2], vlo[2];
#pragma unroll
    for (int i = 0; i < 2; ++i) { const int id = tid + 512 * i, key = id / 12, ch = id % 12; kgo[i] = (unsigned)(key * NQ + ch * 16); klo[i] = (unsigned)(key * PK8_PITCH + ch * 16); }
#pragma unroll
    for (int i = 0; i < 2; ++i) { const int id = tid + 512 * i, key = id >> 4, ch = id & 15; vgo[i] = (unsigned)(key * DM * 2 + ch * 16); vlo[i] = (unsigned)(2 * PK8B + key * PV_PITCH + ch * 16); }
    const bool k2 = tid < 256;
    const __amdgpu_buffer_rsrc_t Krs = __builtin_amdgcn_make_buffer_rsrc((void*)(K8 + row0 * NQ + h * DQ), 0, SEQ * NQ, 0x00020000);
    const __amdgpu_buffer_rsrc_t Vrs = __builtin_amdgcn_make_buffer_rsrc((void*)(VB + row0 * DM + h * DVH), 0, SEQ * DM * 2, 0x00020000);
    v4u kr[2], vr[2];
#define PA_LOAD(t) do { const int kso_ = (t) * (64 * NQ), vso_ = (t) * (64 * DM * 2); \
                        kr[0] = __builtin_amdgcn_raw_buffer_load_b128(Krs, kgo[0], kso_, 0); if (k2) kr[1] = __builtin_amdgcn_raw_buffer_load_b128(Krs, kgo[1], kso_, 0); \
                        _Pragma("unroll") for (int i = 0; i < 2; ++i) vr[i] = __builtin_amdgcn_raw_buffer_load_b128(Vrs, vgo[i], vso_, 0); } while (0)
#define PA_STORE(bufi) do { *(LAS v4u*)(lds + (bufi) * PK8B + klo[0]) = kr[0]; if (k2) *(LAS v4u*)(lds + (bufi) * PK8B + klo[1]) = kr[1]; \
                            _Pragma("unroll") for (int i = 0; i < 2; ++i) *(LAS v4u*)(lds + (bufi) * PVB + vlo[i]) = vr[i]; } while (0)
    __syncthreads();
    PA_LOAD(0); PA_STORE(0);
    __syncthreads();
    const int trq = (lane & 15) >> 2, trp = lane & 3, trblk = (lane >> 4) & 1;
    for (int t = 0; t < NT; ++t) {
        const int bi = t & 1;
        if (t + 1 < NT) PA_LOAD(t + 1);
        const LAS unsigned char* Kb = lds + bi * PK8B; const LAS unsigned char* Vb = lds + 2 * PK8B + bi * PVB;
#pragma unroll
        for (int kb = 0; kb < 2; ++kb) {
            f32x16 S;
#pragma unroll
            for (int r = 0; r < 16; ++r) S[r] = 0.f;
            const LAS unsigned char* kp = Kb + (32 * kb + n) * PK8_PITCH + 32 * hi;
            const LAS unsigned char* vp = Vb + (32 * kb + 4 * hi + trq) * PV_PITCH + (16 * trblk) * 2 + 8 * trp;
            v4u ka[3][2]; s16x4 vl[2][4], vh[2][4];
#pragma unroll
            for (int s = 0; s < 3; ++s) { ka[s][0] = *(const LAS v4u*)(kp + 64 * s); ka[s][1] = *(const LAS v4u*)(kp + 64 * s + 16); }
#pragma unroll
            for (int s2 = 0; s2 < 2; ++s2)
#pragma unroll
                for (int d = 0; d < 4; ++d) { vl[s2][d] = trread(vp + (16 * s2) * PV_PITCH + 64 * d); vh[s2][d] = trread(vp + (16 * s2 + 8) * PV_PITCH + 64 * d); }
            __builtin_amdgcn_sched_barrier(0);
#pragma unroll
            for (int s = 0; s < 3; ++s) S = MFMA8(__builtin_shufflevector(__builtin_bit_cast(v4i_t, ka[s][0]), __builtin_bit_cast(v4i_t, ka[s][1]), 0, 1, 2, 3, 4, 5, 6, 7), qf[s], S);
            __builtin_amdgcn_sched_barrier(0);
            if (t >= NT - 4) {
#pragma unroll
                for (int r = 0; r < 16; ++r) { const int key = 64 * t + 32 * kb + crow(r, hi); if (key > qrow) S[r] = -1e30f; }
            }
            float ls = 0.f;
#pragma unroll
            for (int r = 0; r < 16; ++r) { const float p = fexp2(S[r] * (1.0f / 64.0f) - SM_SHIFT); S[r] = p; ls += p; }
            lrun += ls;
            const bf16x8 p0 = pack8<0>(S), p1 = pack8<1>(S);
#pragma unroll
            for (int s2 = 0; s2 < 2; ++s2) {
                const bf16x8 pf = s2 == 0 ? p0 : p1;
#pragma unroll
                for (int d = 0; d < 4; ++d) O[d] = MFMA32(cat8(vl[s2][d], vh[s2][d]), pf, O[d]);
            }
        }
        if (t + 1 < NT) PA_STORE(bi ^ 1);
        __syncthreads();
    }
#undef PA_LOAD
#undef PA_STORE
    const float linv = 1.0f / (lrun + __shfl_xor(lrun, 32));
    bf16* op = ATT + (row0 + qrow) * DM + h * DVH + 4 * hi;
#pragma unroll
    for (int d = 0; d < 4; ++d)
#pragma unroll
        for (int g = 0; g < 4; ++g) { u32x2 w; w.x = pk2(O[d][4 * g] * linv, O[d][4 * g + 1] * linv); w.y = pk2(O[d][4 * g + 2] * linv, O[d][4 * g + 3] * linv); *(u32x2*)(op + 32 * d + 8 * g) = w; }
}

constexpr int C8_STRIDE = 2080;

constexpr int OI_PITCH = 528;
DI void sample_merge_unit(const Ctx& C, int seq, int rb) {
    const Args& A = *C.a; unsigned char* ws = A.ws; LAS unsigned char* lds = C.lds;
    int tid_ = threadIdx.x; asm volatile("" : "+v"(tid_)); const int tid = tid_, lane = tid & 63, wid = C.wave, n = lane & 31, hi = lane >> 5;
    __syncthreads();
    {
        const int rn = tid & 31, dg = tid >> 5;
        const float* PML = (const float*)(ws + WS_PML); const float* PO = (const float*)(ws + WS_PO);
        const size_t u0 = ((size_t)(seq * 2 + 0) * 2 + rb), u1 = ((size_t)(seq * 2 + 1) * 2 + rb);
        const float m0 = PML[(u0 * 32 + rn) * 2], l0 = PML[(u0 * 32 + rn) * 2 + 1], m1 = PML[(u1 * 32 + rn) * 2], l1 = PML[(u1 * 32 + rn) * 2 + 1];
        const float mt = fmaxf(m0, m1), w0 = fexp2(m0 - mt), w1 = fexp2(m1 - mt), Li = 1.0f / (w0 * l0 + w1 * l1);
#pragma unroll 4
        for (int j = 0; j < 16; ++j) {
            const int dv = dg * 16 + j;
            const float o = w0 * PO[(u0 * 256 + dv) * 32 + rn] + w1 * PO[(u1 * 256 + dv) * 32 + rn];
            *(LAS bf16*)(lds + rn * OI_PITCH + dv * 2) = (bf16)f2bf(o * Li);
        }
    }
    __syncthreads();
    {
        const int hl = wid >> 1, h = 4 * rb + hl, d0 = 2 * (wid & 1);
        const bf16* WUV = (const bf16*)(ws + WS_WUKV) + (size_t)(1024 + h * DVH) * RL; bf16* ATT = (bf16*)(ws + WS_ATT);
        f32x16 acc[2];
#pragma unroll
        for (int d = 0; d < 2; ++d)
#pragma unroll
            for (int r = 0; r < 16; ++r) acc[d][r] = 0.f;
#pragma unroll 4
        for (int s = 0; s < 16; ++s) {
            bf16x8 bfr = *(const LAS bf16x8*)(lds + (hl * 8 + (n & 7)) * OI_PITCH + (16 * s + 8 * hi) * 2);
            if (n >= DEC_T) bfr = (bf16x8){0, 0, 0, 0, 0, 0, 0, 0};
#pragma unroll
            for (int d = 0; d < 2; ++d) acc[d] = MFMA32(*(const bf16x8*)(WUV + (size_t)(32 * (d0 + d) + n) * RL + 16 * s + 8 * hi), bfr, acc[d]);
        }
        if (n < DEC_T) {
            bf16* op = ATT + (size_t)(NP + seq * DEC_T + n) * DM + h * DVH + 4 * hi;
#pragma unroll
            for (int d = 0; d < 2; ++d)
#pragma unroll
                for (int g = 0; g < 4; ++g) { u32x2 w; w.x = pk2(acc[d][4 * g], acc[d][4 * g + 1]); w.y = pk2(acc[d][4 * g + 2], acc[d][4 * g + 3]); *(u32x2*)(op + 32 * (d0 + d) + 8 * g) = w; }
        }
    }
}

constexpr int GV_PITCH = 544;
DI void gmlp_stage(const Ctx& C, int chunk, int g, int boff) {
    unsigned char* ws = C.a->ws; LAS unsigned char* lds = C.lds + boff;
    int tid_ = threadIdx.x; asm volatile("" : "+v"(tid_)); const int tid = tid_;
    const bf16* VN = (const bf16*)(ws + WS_VG); const size_t r0 = (size_t)chunk * 128;
#pragma unroll
    for (int i = 0; i < 8; ++i) { const int id = tid + 512 * i, s = id >> 5, ch = id & 31; *(LAS v4u*)(lds + s * GV_PITCH + ch * 16) = *(const v4u*)(VN + (r0 + s) * DM + g * 256 + ch * 8); }
}
DI void gmlp_compute(const Ctx& C, int chunk, int g, int boff) {
    const Args& A = *C.a; unsigned char* ws = A.ws; LAS unsigned char* lds = C.lds + boff;
    int tid_ = threadIdx.x; asm volatile("" : "+v"(tid_)); const int tid = tid_, lane = tid & 63, wid = C.wave, n = lane & 31, hi = lane >> 5;
    const bf16* U = (const bf16*)(ws + WS_U); const bf16* WST = (const bf16*)(ws + WS_WST) + (size_t)g * 128 * 128; bf16* GM = (bf16*)(ws + WS_GM);
    const float* bs = (const float*)A.in[22] + g * 128;
    const size_t r0 = (size_t)chunk * 128;
    f32x16 acc[4];
#pragma unroll
    for (int tb = 0; tb < 4; ++tb)
#pragma unroll
        for (int r = 0; r < 16; ++r) acc[tb][r] = 0.f;
    const int trq = (lane & 15) >> 2, trp = lane & 3, trblk = (lane >> 4) & 1;
#pragma unroll
    for (int ks = 0; ks < 8; ++ks) {
        const LAS unsigned char* vp = lds + (16 * ks + 8 * hi + trq) * GV_PITCH + (32 * wid + 16 * trblk) * 2 + 8 * trp;
        const bf16x8 af = cat8(trread(vp), trread(vp + 4 * GV_PITCH));
#pragma unroll
        for (int tb = 0; tb < 4; ++tb) {
            if (2 * tb + 1 >= ks) { const bf16x8 bfr = *(const bf16x8*)(WST + (size_t)(32 * tb + n) * 128 + 16 * ks + 8 * hi); acc[tb] = MFMA32(af, bfr, acc[tb]); }
        }
    }
#pragma unroll
    for (int tb = 0; tb < 4; ++tb) {
        const int t = 32 * tb + n; const float bias = bs[t];
        const size_t off = (r0 + t) * DM + g * 256 + 32 * wid + 4 * hi;
#pragma unroll
        for (int q = 0; q < 4; ++q) {
            const u32x2 uu = *(const u32x2*)(U + off + 8 * q);
            u32x2 w; w.x = pk2(bflo(uu.x) * (acc[tb][4 * q] + bias), bfhi(uu.x) * (acc[tb][4 * q + 1] + bias)); w.y = pk2(bflo(uu.y) * (acc[tb][4 * q + 2] + bias), bfhi(uu.y) * (acc[tb][4 * q + 3] + bias));
            *(u32x2*)(GM + off + 8 * q) = w;
        }
    }
}
DI void gmlp_sample_unit(const Ctx& C, int seq) {
    const Args& A = *C.a; unsigned char* ws = A.ws; int tid_ = threadIdx.x; asm volatile("" : "+v"(tid_)); const int lane = tid_ & 63, t = C.wave;
    const bf16* VN = (const bf16*)(ws + WS_VG); const bf16* U = (const bf16*)(ws + WS_U); bf16* GM = (bf16*)(ws + WS_GM);
    const float* wsrc = (const float*)A.in[21]; const float* bsrc = (const float*)A.in[22];
    const size_t r0 = (size_t)NP + (size_t)seq * DEC_T;
#pragma unroll
    for (int g = 0; g < 4; ++g) {
        float a0 = 0.f, a1 = 0.f, a2 = 0.f, a3 = 0.f;
        for (int s = 0; s <= t; ++s) {
            const float w = wsrc[(g * 128 + t) * 128 + s];
            const u32x2 vv = *(const u32x2*)(VN + (r0 + s) * DM + g * 256 + 4 * lane);
            a0 += w * bflo(vv.x); a1 += w * bfhi(vv.x); a2 += w * bflo(vv.y); a3 += w * bfhi(vv.y);
        }
        const float bias = bsrc[g * 128 + t];
        const size_t off = (r0 + t) * DM + g * 256 + 4 * lane;
        const u32x2 uu = *(const u32x2*)(U + off);
        u32x2 w; w.x = pk2(bflo(uu.x) * (a0 + bias), bfhi(uu.x) * (a1 + bias)); w.y = pk2(bflo(uu.y) * (a2 + bias), bfhi(uu.y) * (a3 + bias));
        *(u32x2*)(GM + off) = w;
    }
}

constexpr int FS_C8 = 0, FS_CTP = 544, FS_CT = 20 * C8_STRIDE, FS_Q8 = FS_CT + 128 * FS_CTP, FS_P = FS_Q8 + 10 * C8_STRIDE, FS_RT = FS_P + 16384, FS_END = FS_RT + 4096;
static_assert(FS_END <= MISC_OFF && (FS_CT % 16) == 0 && (FS_Q8 % 16) == 0 && (FS_P % 16) == 0, "fused sample attention LDS map");
DI u32x2 bf8_to_fp8(const v4u w) { return (u32x2){fp8x4(bflo(w.x), bfhi(w.x), bflo(w.y), bfhi(w.y)), fp8x4(bflo(w.z), bfhi(w.z), bflo(w.w), bfhi(w.w))}; }
constexpr int F2_CBUF = 20 * C8_STRIDE, F2_Q8 = 2 * F2_CBUF, F2_P = F2_Q8 + 10 * C8_STRIDE, F2_RT = F2_P + 16384, F2_END = F2_RT + 4096;
static_assert(F2_END <= MISC_OFF && (F2_Q8 % 16) == 0 && (F2_P % 16) == 0, "fused sample attention v2 LDS map");
constexpr float C6_SC = 0.5f;
#define F6_FRAG(pa_, pb_) __builtin_shufflevector(__builtin_bit_cast(v4i_t, *(const LAS v4u*)(pa_)), __builtin_shufflevector(__builtin_bit_cast(v2i_t, *(const LAS u32x2*)(pb_)), __builtin_bit_cast(v2i_t, *(const LAS u32x2*)(pb_)), 0, 1, -1, -1), 0, 1, 2, 3, 4, 5, 6, 7)
#define CVTF8(a, b) (u32x2){fp8x4((a)[0], (a)[1], (a)[2], (a)[3]), fp8x4((b)[0], (b)[1], (b)[2], (b)[3])}
DI void fused_sample_unit2(const Ctx& C, int seq, int half, const int pflags = 0) {
#define FSU2_SIG
    const Args& A = *C.a; unsigned char* ws = A.ws; LAS unsigned char* lds = C.lds;
    const int wid = C.wave;
#define LANE_NOW() ((int)__builtin_amdgcn_mbcnt_hi(~0u, __builtin_amdgcn_mbcnt_lo(~0u, 0u)))
#define OPQ_TID(t) int t = wid * 64 + LANE_NOW(); asm volatile("" : "+v"(t))
#define OPQ_LANE(l_, n_, h_) int l_ = LANE_NOW(); asm volatile("" : "+v"(l_)); const int n_ = l_ & 31, h_ = l_ >> 5
    const int* pt = (const int*)A.in[4] + seq * NPAGES;
    int ptv; { const int l_ = LANE_NOW() & 31; ptv = pt[half * 32 + l_]; }
    const bf16* QN = (const bf16*)(ws + WS_QN); const bf16* WUKO = (const bf16*)(ws + WS_WUKO);
    const __amdgpu_buffer_rsrc_t Lrs = __builtin_amdgcn_make_buffer_rsrc((void*)A.in[2], 0, 0x50000000u, 0x00020000);
    const __amdgpu_buffer_rsrc_t Rrs = __builtin_amdgcn_make_buffer_rsrc((void*)A.in[3], 0, 0x14000000u, 0x00020000);
    const __amdgpu_buffer_rsrc_t Wrs = __builtin_amdgcn_make_buffer_rsrc((void*)(ws + WS_WF + (size_t)wid * 24576), 0, 24576, 0x00020000);
    const __amdgpu_buffer_rsrc_t NRrs = __builtin_amdgcn_make_buffer_rsrc((void*)((const float*)(ws + WS_RS) + ((size_t)seq * SKEYS + PAST) * NH), 0, DEC_T * NH * 4, 0x00020000);
    const __amdgpu_buffer_rsrc_t NLrs = __builtin_amdgcn_make_buffer_rsrc((void*)((const bf16*)(ws + WS_LATB) + (size_t)(NP + seq * DEC_T) * RL), 0, DEC_T * RL * 2, 0x00020000);
    const __amdgpu_buffer_rsrc_t NKrs = __builtin_amdgcn_make_buffer_rsrc((void*)((const bf16*)(ws + WS_KRB) + (size_t)(NP + seq * DEC_T) * DR), 0, DEC_T * DR * 2, 0x00020000);
#define LBAR2() do { asm volatile("s_waitcnt lgkmcnt(0)" ::: "memory"); __builtin_amdgcn_s_barrier(); asm volatile("" ::: "memory"); } while (0)
#define LDF4(rs, vo, so) __builtin_bit_cast(f32x4, __builtin_amdgcn_raw_buffer_load_b128(rs, vo, so, 0))
#define CVT8(a, b) (v4u){pk2((a)[0], (a)[1]), pk2((a)[2], (a)[3]), pk2((b)[0], (b)[1]), pk2((b)[2], (b)[3])}
    __syncthreads();
    {
        const int h = wid; OPQ_LANE(lane, n, hi);
        bf16x8 bq[8];
        const __amdgpu_buffer_rsrc_t Qrs = __builtin_amdgcn_make_buffer_rsrc((void*)(QN + (size_t)(NP + seq * DEC_T) * NQ), 0, DEC_T * NQ * 2, 0x00020000);
        const __amdgpu_buffer_rsrc_t WOrs = __builtin_amdgcn_make_buffer_rsrc((void*)WUKO, 0, RL * 1024 * 2, 0x00020000);
        const unsigned qvo = (unsigned)(((n & 7) * NQ + h * DQ + 8 * hi) * 2), wvo0 = (unsigned)((n * 1024 + h * DN + 8 * hi) * 2);
#pragma unroll
        for (int s = 0; s < 8; ++s) { bq[s] = __builtin_bit_cast(bf16x8, __builtin_amdgcn_raw_buffer_load_b128(Qrs, qvo, 32 * s, 0)); if (n >= DEC_T) bq[s] = (bf16x8){0, 0, 0, 0, 0, 0, 0, 0}; }
#pragma unroll 2
        for (int jb = 0; jb < 8; ++jb) {
            f32x16 acc;
#pragma unroll
            for (int r = 0; r < 16; ++r) acc[r] = 0.f;
#pragma unroll
            for (int s = 0; s < 8; ++s) acc = MFMA32(__builtin_bit_cast(bf16x8, __builtin_amdgcn_raw_buffer_load_b128(WOrs, wvo0, jb * (32 * 1024 * 2) + 32 * s, 0)), bq[s], acc);
            if (n < DEC_T) {
                const int row = h * 8 + n, rbq = row >> 5;
#pragma unroll
                for (int r = 0; r < 16; ++r) {
                    const int jl = 32 * jb + crow(r, hi), j = 32 * ((jl >> 3) & 7) + 8 * (jl >> 6) + 2 * (jl & 3) + ((jl >> 2) & 1);
                    const unsigned b8 = fp8x4(64.f * acc[r], 0.f, 0.f, 0.f) & 0xffu;
                    *(LAS unsigned char*)(lds + F2_Q8 + (rbq * 5 + (j >> 6)) * C8_STRIDE + ((j >> 5) & 1) * 1040 + ((row & 31) + 32 * ((j >> 4) & 1)) * 16 + (j & 15)) = (unsigned char)b8;
                }
            }
        }
        {
            OPQ_TID(tq_); const int row = tq_ >> 3, c8 = tq_ & 7, hh = row >> 3, q = row & 7;
            const v4u v = __builtin_amdgcn_raw_buffer_load_b128(Qrs, (unsigned)((q * NQ + hh * DQ + DN + c8 * 8) * 2), 0, 0);
            const u32x2 f = (u32x2){fp8x4(64.f * bflo(v.x), 64.f * bfhi(v.x), 64.f * bflo(v.y), 64.f * bfhi(v.y)), fp8x4(64.f * bflo(v.z), 64.f * bfhi(v.z), 64.f * bflo(v.w), 64.f * bfhi(v.w))};
            *(LAS u32x2*)(lds + F2_Q8 + ((row >> 5) * 5 + 4) * C8_STRIDE + ((c8 >> 1) & 1) * 1040 + ((row & 31) + 32 * ((c8 >> 2) & 1)) * 16 + (c8 & 1) * 8) = f;
        }
    }
    const int rb = wid >> 2, jq = wid & 3;
    v4u wfa[4]; u32x2 wfb[4];
    { const unsigned wvo = (unsigned)LANE_NOW() * 16u;
#pragma unroll
    for (int i = 0; i < 4; ++i) { wfa[i] = __builtin_amdgcn_raw_buffer_load_b128(Wrs, wvo, i * 1536, 0); wfb[i] = __builtin_bit_cast(u32x2, __builtin_amdgcn_raw_buffer_load_b64(Wrs, wvo >> 1, i * 1536 + 1024, 0)); } }
#define LGO_(t) ((unsigned)(((t) >> 3) * RL * 4 + ((t) & 7) * 32))
#define RGO_(t) ((unsigned)(((t) >> 3) * DR * 4 + ((t) & 7) * 32))
#define CT_ITEM(t) ((unsigned)(FS_CT + ((t) >> 5) * FS_CTP + ((t) & 31) * 16))
#define C6_FRAG(t) ((unsigned)(((((t) >> 8) & 1) * 5 + (((t) & 7) >> 1)) * C8_STRIDE))
#define C6_LANE(t) ((((t) >> 3) & 31) + 32 * ((t) & 1))
#define R8_ITEM(t) ((unsigned)(FS_C8 + ((((t) >> 3) >> 5) * 5 + 4) * C8_STRIDE + ((((t) & 7) >> 1) & 1) * 1040 + ((((t) >> 3) & 31) + 32 * ((((t) & 7) >> 2) & 1)) * 16 + ((t) & 1) * 8))
    f32x16 O[2];
#pragma unroll
    for (int d = 0; d < 2; ++d)
#pragma unroll
        for (int r = 0; r < 16; ++r) O[d][r] = 0.f;
    float lrun = 0.f;
    const int p0 = half * 32, np = 32 + half;
#define F_WRUNIT(u_, base_) do { OPQ_TID(t6_); const v6u_t v6_ = f6x32(RA[0], RA[1], RA[2], RA[3], RB[0], RB[1], RB[2], RB[3], C6_SC); LAS unsigned char* fb_ = lds + (base_) + C6_FRAG(t6_) + (u_) * (10 * C8_STRIDE); *(LAS v4u*)(fb_ + C6_LANE(t6_) * 16) = (v4u){v6_[0], v6_[1], v6_[2], v6_[3]}; *(LAS u32x2*)(fb_ + 1040 + C6_LANE(t6_) * 8) = (u32x2){v6_[4], v6_[5]}; } while (0)
#define F_LDUNIT(so) do { OPQ_TID(t2_); const unsigned lgo = LGO_(t2_); _Pragma("unroll") for (int k = 0; k < 4; ++k) { RA[k] = LDF4(Lrs, lgo + 256 * k, (so)); RB[k] = LDF4(Lrs, lgo + 256 * k + 16, (so)); } } while (0)
    {
        f32x4 RA[4], RB[4];
        const unsigned sp = (unsigned)__builtin_amdgcn_readlane(ptv, 0); const unsigned sl = sp * (unsigned)(PAGE * RL * 4), sr = sp * (unsigned)(PAGE * DR * 4);
        F_LDUNIT(sl); F_WRUNIT(0, 0);
        F_LDUNIT(sl + 65536); F_WRUNIT(1, 0);
        OPQ_TID(t0_); const unsigned rgo = RGO_(t0_); const unsigned r8_item = R8_ITEM(t0_);
#pragma unroll
        for (int k = 0; k < 2; ++k) { const f32x4 a = LDF4(Rrs, rgo, sr + k * 16384), b = LDF4(Rrs, rgo + 16, sr + k * 16384); *(LAS u32x2*)(lds + r8_item + k * (10 * C8_STRIDE)) = CVTF8(a, b); }
    }
    int cur = 0;
    for (int ip = 0; ip < np; ++ip) {
        const bool newtile = ip == 32;
        LBAR2();
        const int cb0 = cur * F2_CBUF, nb0 = (cur ^ 1) * F2_CBUF;
        OPQ_TID(tn_);
        if (newtile && tn_ < 256) {
            const int key = tn_ >> 1, h4 = (tn_ & 1) * 4;
            f32x4 rv = {0.f, 0.f, 0.f, 0.f};
            rv = __builtin_bit_cast(f32x4, __builtin_amdgcn_raw_buffer_load_b128(NRrs, (unsigned)((key * NH + h4) * 4), 0, 0));
            *(LAS f32x4*)(lds + F2_RT + (key * 8 + h4) * 4) = rv;
        }
        const int ipn = ip + 1; const bool hn = ipn < np, nnew = ipn == 32;
        const unsigned spn = (unsigned)__builtin_amdgcn_readlane(ptv, (hn && !nnew && !(pflags & 1)) ? ipn : 0);
        const unsigned sl = spn * (unsigned)(PAGE * RL * 4), sr = spn * (unsigned)(PAGE * DR * 4);
        f32x4 RA[4], RB[4], RR[4];
        if (!newtile && !(pflags & 2)) {
            float ssq[4] = {0.f, 0.f, 0.f, 0.f};
            int ln1 = LANE_NOW(); asm volatile("" : "+v"(ln1)); const LAS unsigned char* cbuf = lds + cb0 + ln1 * 16; const LAS unsigned char* cbufb = lds + cb0 + 1040 + ln1 * 8; const unsigned wvo = (unsigned)ln1 * 16u, wvob = (unsigned)ln1 * 8u;
#define F_RD1(da_, db2_, s_, kb_) do { da_ = *(const LAS v4u*)(cbuf + ((kb_) * 5 + (s_)) * C8_STRIDE); db2_ = *(const LAS u32x2*)(cbufb + ((kb_) * 5 + (s_)) * C8_STRIDE); } while (0)
#define F6_OP(a_, b_) __builtin_shufflevector(__builtin_bit_cast(v4i_t, a_), __builtin_shufflevector(__builtin_bit_cast(v2i_t, b_), __builtin_bit_cast(v2i_t, b_), 0, 1, -1, -1), 0, 1, 2, 3, 4, 5, 6, 7)
#define F_MM1(sa_, sb_, s_, kb_) do { __builtin_amdgcn_s_setprio(1); acc[kb_] = __builtin_amdgcn_mfma_scale_f32_32x32x64_f8f6f4(F6_OP(wfa[s_], wfb[s_]), F6_OP(sa_, sb_), acc[kb_], 2, 2, 0, 0, 0, 0); __builtin_amdgcn_s_setprio(0); } while (0)
#define F_WRL(s_) do { wfa[s_] = __builtin_amdgcn_raw_buffer_load_b128(Wrs, wvo, wnext + (s_) * 1536, 0); wfb[s_] = __builtin_bit_cast(u32x2, __builtin_amdgcn_raw_buffer_load_b64(Wrs, wvob, wnext + (s_) * 1536 + 1024, 0)); } while (0)
#define F_DBBODY(db_, PRE, POST) do { \
            const int wnext = (((db_) + 1) & 3) * 6144; \
            f32x16 acc[4]; \
            _Pragma("unroll") for (int kb = 0; kb < 4; ++kb) _Pragma("unroll") for (int r = 0; r < 16; ++r) acc[kb][r] = 0.f; \
            v4u caa[3]; u32x2 cab[3]; \
            _Pragma("unroll") for (int s = 0; s < 4; ++s) { \
                F_RD1(caa[0], cab[0], s, 0); F_RD1(caa[1], cab[1], s, 1); F_RD1(caa[2], cab[2], s, 2); \
                if (s == 0) { PRE; } \
                if (s == 1) { POST; } \
                F_MM1(caa[0], cab[0], s, 0); __builtin_amdgcn_sched_barrier(0); F_RD1(caa[0], cab[0], s, 3); F_MM1(caa[1], cab[1], s, 1); F_MM1(caa[2], cab[2], s, 2); F_MM1(caa[0], cab[0], s, 3); F_WRL(s); \
                __builtin_amdgcn_sched_barrier(0); \
            } \
            _Pragma("unroll") for (int kb = 0; kb < 4; ++kb) _Pragma("unroll") for (int r = 0; r < 16; ++r) ssq[kb] += acc[kb][r] * acc[kb][r]; \
            __builtin_amdgcn_sched_barrier(0); } while (0)
            const bool pf = hn && !nnew;
#pragma nounroll
            for (int d2 = 0; d2 < 2; ++d2) {
                F_DBBODY(2 * d2, (void)0, if (pf && d2 == (wid >> 2)) { F_LDUNIT(sl); });
                F_DBBODY(2 * d2 + 1, (void)0, (void)0);
            }
#undef F_RD1
#undef F_MM1
#undef F6_OP
#undef F_WRL
#undef F_DBBODY
#pragma unroll
            for (int kb = 0; kb < 4; ++kb) {
                const float tt = ssq[kb] + __shfl_xor(ssq[kb], 32);
                if ((ln1 >> 5) == 0) *(LAS float*)(lds + F2_RT + ((32 * kb + (ln1 & 31)) * 8 + wid) * 4) = rsqrtf(tt * (1.0f / (128.0f * 4096.0f)) + EPS);
            }
        }
        if (hn && !nnew) {
            F_WRUNIT(0, nb0); F_LDUNIT(sl + 65536);
            OPQ_TID(t3_); const unsigned rgo = RGO_(t3_);
            RR[0] = LDF4(Rrs, rgo, sr); RR[1] = LDF4(Rrs, rgo + 16, sr); RR[2] = LDF4(Rrs, rgo, sr + 16384); RR[3] = LDF4(Rrs, rgo + 16, sr + 16384);
        }
        LBAR2();
        f32x16 Sn, Sr;
#pragma unroll
        for (int r = 0; r < 16; ++r) { Sn[r] = 0.f; Sr[r] = 0.f; }
        int ln2 = LANE_NOW(); asm volatile("" : "+v"(ln2)); const int n2 = ln2 & 31, hi2 = ln2 >> 5, myh = 4 * rb + (n2 >> 3), myq = n2 & 7;
        {
            const LAS unsigned char* kf = lds + cb0 + (jq * 5) * C8_STRIDE + ln2 * 16; const LAS unsigned char* kfb = lds + cb0 + (jq * 5) * C8_STRIDE + 1040 + ln2 * 8; const LAS unsigned char* qf = lds + F2_Q8 + (rb * 5) * C8_STRIDE + ln2 * 16;
#pragma unroll
            for (int s = 0; s < 5; ++s) {
                const v8i_t ka = s < 4 ? F6_FRAG(kf + s * C8_STRIDE, kfb + s * C8_STRIDE) : __builtin_shufflevector(__builtin_bit_cast(v4i_t, *(const LAS v4u*)(kf + s * C8_STRIDE)), __builtin_bit_cast(v4i_t, *(const LAS v4u*)(kf + s * C8_STRIDE + 1040)), 0, 1, 2, 3, 4, 5, 6, 7);
                const v8i_t qa = __builtin_shufflevector(__builtin_bit_cast(v4i_t, *(const LAS v4u*)(qf + s * C8_STRIDE)), __builtin_bit_cast(v4i_t, *(const LAS v4u*)(qf + s * C8_STRIDE + 1040)), 0, 1, 2, 3, 4, 5, 6, 7);
                if (s < 4) Sn = __builtin_amdgcn_mfma_scale_f32_32x32x64_f8f6f4(ka, qa, Sn, 2, 0, 0, 0, 0, 0);
                else       Sr = __builtin_amdgcn_mfma_scale_f32_32x32x64_f8f6f4(ka, qa, Sr, 0, 0, 0, 0, 0, 0);
                __builtin_amdgcn_sched_barrier(0);
            }
        }
        float ls = 0.f;
#pragma unroll
        for (int r = 0; r < 16; ++r) {
            const int kl = 32 * jq + crow(r, hi2);
            const float s = (Sn[r] * (0.5f * *(const LAS float*)(lds + F2_RT + (kl * 8 + myh) * 4)) + Sr[r]) * (1.0f / 64.0f);
            const float p = (newtile && kl > myq) ? 0.f : fexp2(s - SM_SHIFT);
            Sn[r] = p; ls += p;
        }
        lrun += ls;
        *(LAS bf16x8*)(lds + F2_P + ((rb * 4 + jq) * 2 + 0) * 1024 + ln2 * 16) = pack8<0>(Sn);
        *(LAS bf16x8*)(lds + F2_P + ((rb * 4 + jq) * 2 + 1) * 1024 + ln2 * 16) = pack8<1>(Sn);
        LBAR2();
        {
            int ln3 = LANE_NOW(); asm volatile("" : "+v"(ln3)); const int n3 = ln3 & 31, kh3 = ln3 >> 5;
            const LAS unsigned char* pbase = lds + F2_P + rb * 8192 + ln3 * 16;
            const LAS unsigned char* cfb = lds + cb0 + jq * C8_STRIDE + ln3 * 16; const LAS unsigned char* cfbb = lds + cb0 + jq * C8_STRIDE + 1040 + ln3 * 8;
            v8i_t idm[2];
#pragma unroll
            for (int d = 0; d < 2; ++d)
#pragma unroll
                for (int w = 0; w < 8; ++w) idm[d][w] = (kh3 == d && ((6 * n3 + 3) >> 5) == w) ? (int)(1u << ((6 * n3 + 3) & 31)) : 0;
#pragma unroll
            for (int kq = 0; kq < 4; ++kq) {
                const v8i_t cf = F6_FRAG(cfb + kq * (5 * C8_STRIDE), cfbb + kq * (5 * C8_STRIDE));
                const bf16x8 pf0 = *(const LAS bf16x8*)(pbase + (2 * kq) * 1024), pf1 = *(const LAS bf16x8*)(pbase + (2 * kq + 1) * 1024);
#pragma unroll
                for (int d = 0; d < 2; ++d) {
                    f32x16 T;
#pragma unroll
                    for (int r = 0; r < 16; ++r) T[r] = 0.f;
                    T = __builtin_amdgcn_mfma_scale_f32_32x32x64_f8f6f4(cf, idm[d], T, 2, 2, 0, 0, 0, 0);
                    O[d] = MFMA32(pack8<0>(T), pf0, O[d]);
                    O[d] = MFMA32(pack8<1>(T), pf1, O[d]);
                }
            }
        }
        if (hn && !nnew) {
            F_WRUNIT(1, nb0);
            OPQ_TID(t7_); LAS unsigned char* rd_ = lds + nb0 + R8_ITEM(t7_);
            *(LAS u32x2*)rd_ = CVTF8(RR[0], RR[1]); *(LAS u32x2*)(rd_ + 10 * C8_STRIDE) = CVTF8(RR[2], RR[3]);
        } else if (nnew) {
            OPQ_TID(t4_);
            {
#pragma unroll
                for (int k = 0; k < 4; ++k) { const v4u l = __builtin_amdgcn_raw_buffer_load_b128(NLrs, (unsigned)((t4_ >> 3) * RL * 2 + 128 * k + (t4_ & 7) * 16), 0, 0);
                    RA[k] = (f32x4){bflo(l.x), bfhi(l.x), bflo(l.y), bfhi(l.y)}; RB[k] = (f32x4){bflo(l.z), bfhi(l.z), bflo(l.w), bfhi(l.w)}; }
                F_WRUNIT(0, nb0); }
            const v4u kv = __builtin_amdgcn_raw_buffer_load_b128(NKrs, (unsigned)((t4_ >> 3) * DR * 2 + (t4_ & 7) * 16), 0, 0);
            *(LAS u32x2*)(lds + nb0 + R8_ITEM(t4_)) = bf8_to_fp8(kv);
        }
        cur ^= 1;
    }
#undef F_LDUNIT
#undef F_WRUNIT
    float ltot = lrun + __shfl_xor(lrun, 32);
    OPQ_LANE(lane, n, hi);
    LBAR2();
    if (hi == 0) *(LAS float*)(lds + F2_RT + ((rb * 4 + jq) * 32 + n) * 4) = ltot;
    LBAR2();
    { const LAS float* st = (const LAS float*)(lds + F2_RT + (rb * 4 * 32 + n) * 4); ltot = (st[0] + st[32]) + (st[64] + st[96]); }
    float* PO = (float*)(ws + WS_PO) + ((size_t)(seq * 2 + half) * 2 + rb) * (256 * 32);
#pragma unroll
    for (int d = 0; d < 2; ++d)
#pragma unroll
        for (int r = 0; r < 16; ++r) { const int pp = 64 * jq + 32 * d + crow(r, hi); PO[(64 * ((pp & 31) >> 3) + 8 * (pp >> 5) + 4 * (pp & 1) + ((pp >> 1) & 3)) * 32 + n] = 0.5f * O[d][r]; }
    if (hi == 0 && jq == 0) { float* pm = (float*)(ws + WS_PML) + (((size_t)(seq * 2 + half) * 2 + rb) * 32 + n) * 2; pm[0] = 0.f; pm[1] = ltot; }
    LBAR2();
#undef LBAR2
#undef LDF4
#undef CVT8
#undef OPQ_LANE
#undef LANE_NOW
#undef OPQ_TID
#undef LGO_
#undef RGO_
#undef CT_ITEM
#undef C6_FRAG
#undef C6_LANE
#undef R8_ITEM
}
#undef CVTF8

#ifndef PH_MASK
#define PH_MASK 0xffff
#endif
#define PH(k) (((PH_MASK) >> (k)) & 1)
__global__ void __launch_bounds__(NWAVES * 64, 2) fused_fwd(Args args) {
    extern __shared__ __attribute__((aligned(16))) unsigned char lds_raw[];
    Ctx C;
    C.lds = (LAS unsigned char*)lds_raw; C.tid = threadIdx.x; C.lane = C.tid & 63; C.wave = __builtin_amdgcn_readfirstlane(C.tid >> 6);
    C.G = gridDim.x; { const int bx = blockIdx.x; C.vcu = (C.G % 8 == 0) ? (bx % 8) * (C.G / 8) + bx / 8 : bx; }
    C.a = &args;
    unsigned char* ws = args.ws;
    volatile LAS unsigned* MISC = (volatile LAS unsigned*)(C.lds + MISC_OFF);
    for (int u = C.tid; u < (LDS_BYTES - MISC_OFF) / 4; u += NWAVES * 64) ((LAS unsigned*)(C.lds + MISC_OFF))[u] = 0u;
    __syncthreads();
    XcdBarrier bar = xcd_barrier_post((unsigned*)(ws + WS_CTL) + CW_BAR, MISC + 8);
#define GRID_BAR() xcd_barrier(bar)
    float* X = args.out + OUT_X;
    bf16* Abuf = (bf16*)(ws + WS_A); bf16* H = (bf16*)(ws + WS_H);
    const int bx = (int)blockIdx.x;

    if (PH(0)) {
    p0_prologue(C);
#ifdef DUP_P0
    p0_prologue(C);
#endif
    }
    GRID_BAR();
    if (PH(1)) {
    {   pg8::Gemm g{Abuf, (const bf16*)(ws + WS_W1GU), MT, NGU, DM}; pg8::StaticOrder S; S.init(MT, NGU, C.G, bx);
        Epi<E_SWIGLU> E{}; E.o0 = H; E.ldc = DFF;
        pg8::gemm_phase<Epi<E_SWIGLU>, pg8::StaticOrder, true, true>(C.lds, g, S, E); }
    }
    GRID_BAR();
    if (PH(2)) {
    {   pg8::Gemm g{H, (const bf16*)(ws + WS_W1D), NP, DM, DFF}; pg8::StaticOrder S; S.init(NP, DM, C.G, bx);
        Epi<E_RESIDN> E{}; E.f0 = X; E.b0 = (const float*)args.in[0]; E.b1 = (const float*)args.in[1]; E.scale = 0.5f;
        E.an = Abuf; E.gn = (const float*)args.in[9]; E.rsp = (float*)(ws + WS_RSP);
        pg8::gemm_phase<Epi<E_RESIDN>, pg8::StaticOrder, true, true>(C.lds, g, S, E);
        gemm_small(C, H, (const bf16*)(ws + WS_W1D), DM, DFF, E); }
    }
    GRID_BAR();
    if (PH(4)) {
    {
        { const float* gq = (const float*)args.in[11]; const float* gkv = (const float*)args.in[13]; const float* gv = (const float*)args.in[20];
          LAS float* G = (LAS float*)(C.lds + XCH_OFF + 4096);
          for (int i = C.tid; i < 1536; i += NWAVES * 64) G[i] = i < 256 ? gq[i] : i < 512 ? gkv[i - 256] : gv[i - 512];
          __syncthreads(); }
        pg8::Gemm g{Abuf, (const bf16*)(ws + WS_WIN), MT, 4608, DM}; pg8::StaticOrder S; S.init(MT, 4608, C.G, bx);
        Epi<E_WIN> E{}; E.wsb = ws; E.outp = args.out; E.xch = C.lds + XCH_OFF; E.ord = 0;
        fill_rowscale(C, S, (const float*)(ws + WS_RSP));
        pg8::gemm_phase<Epi<E_WIN>, pg8::StaticOrder, true, true>(C.lds, g, S, E);
        krope_gemm(C); }
    }
#if defined(DUP_PHASE) && DUP_PHASE == 4
#endif
    GRID_BAR();
    if (PH(6)) {
    int kq_ = RL; asm volatile("" : "+s"(kq_));
    {   const float* gqn = (const float*)args.in[16]; const float* gqr = (const float*)args.in[17]; const float* gkn = (const float*)args.in[18];
        LAS float* G = (LAS float*)(C.lds + XCH_OFF + 8192);
        for (int i = C.tid; i < 320; i += NWAVES * 64) G[i] = i < 128 ? gqn[i] : i < 192 ? gqr[i - 128] : gkn[i - 192];
        __syncthreads(); }
    {
        static_assert(WS_LATB == WS_CQN + (size_t)MT * RL * 2 && WS_WUKV == WS_WUQ + (size_t)NQ * RL * 2, "concatenated operands of the q / latent-expansion stream");
        pg8::Gemm g{(const bf16*)(ws + WS_CQN), (const bf16*)(ws + WS_WUQ), 2 * MT, NQ + 2048, kq_};
        pg8::CatOrder S; S.S1.init(MT, NQ, C.G, bx); S.S2.init(MT, 2048, C.G, bx); S.dpm = MT / 256; S.dpn = NQ / 256;
        Epi<E_QKVN> E{}; E.wsb = ws; E.xch = C.lds + XCH_OFF;
        pg8::gemm_phase<Epi<E_QKVN>, pg8::CatOrder, true, true>(C.lds, g, S, E); }
    }
    GRID_BAR();
    if (PH(8)) {
    {
        const unsigned char* QN = ws + WS_Q8; const unsigned char* K192 = ws + WS_K8; const bf16* VB = (const bf16*)(ws + WS_VB); bf16* ATT = (bf16*)(ws + WS_ATT);
#ifndef P8SEL
#define P8SEL 15
#endif
        if (P8SEL & 1) for (int pu = C.vcu; pu < 256; pu += C.G) {
            const int bh = pu >> 3, s = pu & 7;
            attn_prompt_unit(C, QN, K192, VB, ATT, bh >> 3, bh & 7, 15 - s);
            attn_prompt_unit(C, QN, K192, VB, ATT, bh >> 3, bh & 7, s);
#ifdef DUP_PATTN
            attn_prompt_unit(C, QN, K192, VB, ATT, bh >> 3, bh & 7, 15 - s);
            attn_prompt_unit(C, QN, K192, VB, ATT, bh >> 3, bh & 7, s);
#endif
        }
#ifdef DUP_SATTN
        for (int su = C.vcu; su < 2 * DEC_B; su += C.G) fused_sample_unit2(C, su >> 1, su & 1, DUP_SATTN);
#endif
        if (P8SEL & 2) for (int su = C.vcu; su < 2 * DEC_B; su += C.G) fused_sample_unit2(C, su >> 1, su & 1);
        if (P8SEL & 4) for (int gu = C.vcu; gu < 512; gu += 2 * C.G) {
            const int gu2 = gu + C.G; const bool two = gu2 < 512;
            __syncthreads();
            gmlp_stage(C, gu >> 2, gu & 3, 0); if (two) gmlp_stage(C, gu2 >> 2, gu2 & 3, 128 * GV_PITCH);
            __syncthreads();
            gmlp_compute(C, gu >> 2, gu & 3, 0); if (two) gmlp_compute(C, gu2 >> 2, gu2 & 3, 128 * GV_PITCH);
        }
        if (P8SEL & 8) for (int sq = C.vcu; sq < DEC_B; sq += C.G) gmlp_sample_unit(C, sq);
    }
    }
    GRID_BAR();
    if (PH(9)) {
    for (int mu = C.vcu; mu < 2 * DEC_B; mu += C.G) sample_merge_unit(C, mu >> 1, mu & 1);
    }
    GRID_BAR();
    if (PH(10)) {
    {
        static_assert(WS_GM == WS_ATT + (size_t)MT * DM * 2 && WS_WOG == WS_WOA + (size_t)DM * DM * 2, "concatenated operands of the gated-projection stream");
        pg8::Gemm g{(const bf16*)(ws + WS_ATT), (const bf16*)(ws + WS_WOA), 2 * MT, 2 * DM, DM};
        pg8::CatOrder S; S.S1.init(NP, DM, C.G, bx); S.S2.init(NP, DM, C.G, bx); S.dpm = MT / 256; S.dpn = DM / 256;
        Epi<E_GATEAB> E{}; E.f0 = (float*)(ws + WS_M1); E.g0 = (const bf16*)(ws + WS_GA); E.g1 = (const bf16*)(ws + WS_GG); E.o0 = (bf16*)(ws + WS_MRG);
        pg8::gemm_phase<Epi<E_GATEAB>, pg8::CatOrder, true, true>(C.lds, g, S, E); }
    {   Epi<E_GATEA> E{}; E.f0 = (float*)(ws + WS_M1); E.g0 = (const bf16*)(ws + WS_GA);
        gemm_small(C, (const bf16*)(ws + WS_ATT), (const bf16*)(ws + WS_WOA), DM, DM, E); }
    {   Epi<E_GATEB> E{}; E.o0 = (bf16*)(ws + WS_MRG); E.f0 = (float*)(ws + WS_M1); E.g0 = (const bf16*)(ws + WS_GG);
        gemm_small(C, (const bf16*)(ws + WS_GM), (const bf16*)(ws + WS_WOG), DM, DM, E); }
    }
    GRID_BAR();
    if (PH(11)) {
    {   pg8::Gemm g{(const bf16*)(ws + WS_MRG), (const bf16*)(ws + WS_WOUT), NP, DM, DM}; pg8::StaticOrder S; S.init(NP, DM, C.G, bx);
        Epi<E_RESIDN> E{}; E.f0 = X; E.b0 = X; E.b1 = X + (size_t)NP * DM; E.scale = 1.0f;
        E.an = Abuf; E.gn = (const float*)args.in[26]; E.rsp = (float*)(ws + WS_RSP + RSP_TAB);
        pg8::gemm_phase<Epi<E_RESIDN>, pg8::StaticOrder, true, true>(C.lds, g, S, E);
        gemm_small(C, (const bf16*)(ws + WS_MRG), (const bf16*)(ws + WS_WOUT), DM, DM, E); }
    }
    GRID_BAR();
    if (PH(13)) {
    {   pg8::Gemm g{Abuf, (const bf16*)(ws + WS_W2GU), MT, NGU, DM}; pg8::StaticOrder S; S.init(MT, NGU, C.G, bx);
        Epi<E_SWIGLUN> E{}; E.o0 = H; E.ldc = DFF; E.xch = C.lds + XCH_OFF; E.ord = 0;
        fill_rowscale(C, S, (const float*)(ws + WS_RSP + RSP_TAB));
        pg8::gemm_phase<Epi<E_SWIGLUN>, pg8::StaticOrder, true, true>(C.lds, g, S, E); }
    }
    GRID_BAR();
    if (PH(14)) {
    {   pg8::Gemm g{H, (const bf16*)(ws + WS_W2D), NP, DM, DFF}; pg8::StaticOrder S; S.init(NP, DM, C.G, bx);
        Epi<E_RESID> E{}; E.f0 = X; E.b0 = X; E.b1 = X + (size_t)NP * DM; E.scale = 0.5f;
        pg8::gemm_phase<Epi<E_RESID>, pg8::StaticOrder, true, true>(C.lds, g, S, E);
        gemm_small(C, H, (const bf16*)(ws + WS_W2D), DM, DFF, E); }
    }
#undef GRID_BAR
}

extern "C" void kernel_launch(void* const* d_in, const int* in_sizes, int n_in, void* d_out, int out_size, void* d_ws, size_t ws_size, hipStream_t stream) {
    static int grid = 0;
    if (grid == 0) {
        if (n_in != 30 || (size_t)out_size != OUT_END || ws_size < WS_END) { fprintf(stderr, "kernel_launch: unexpected shapes (n_in %d, out %d, ws %zu; need ws >= %zu)\n", n_in, out_size, ws_size, (size_t)WS_END); grid = -1; return; }
        int dev = 0, cus = 0, per_cu = 0;
        if (hipGetDevice(&dev) != hipSuccess || hipDeviceGetAttribute(&cus, hipDeviceAttributeMultiprocessorCount, dev) != hipSuccess) { grid = -1; return; }
        if (hipFuncSetAttribute((const void*)fused_fwd, hipFuncAttributeMaxDynamicSharedMemorySize, LDS_BYTES) != hipSuccess) { fprintf(stderr, "kernel_launch: hipFuncSetAttribute failed\n"); grid = -1; return; }
        if (hipOccupancyMaxActiveBlocksPerMultiprocessor(&per_cu, (const void*)fused_fwd, NWAVES * 64, LDS_BYTES) != hipSuccess || per_cu < 1)
            fprintf(stderr, "kernel_launch: note: occupancy query reports %d workgroups per CU\n", per_cu);
        (void)hipGetLastError();
        grid = cus;
    }
    if (grid < 0) return;
    if (hipMemsetAsync((char*)d_ws + WS_CTL + (size_t)CW_BAR * 4, 0, (size_t)XCD_BAR_WORDS * 4, stream) != hipSuccess) { fprintf(stderr, "kernel_launch: memset failed\n"); return; }
    Args a{};
    for (int i = 0; i < 30; ++i) a.in[i] = d_in[i];
    a.out = (float*)d_out; a.ws = (unsigned char*)d_ws;
    hipLaunchKernelGGL(fused_fwd, dim3(grid), dim3(NWAVES * 64), LDS_BYTES, stream, a);
    const hipError_t le = hipPeekAtLastError();
    if (le != hipSuccess) fprintf(stderr, "kernel_launch: launch failed: %s\n", hipGetErrorName(le));
}
```
